# Optimizing an MI355X kernel written in HIP

```python
import jax, jax.numpy as jnp
from jax import lax
import numpy as np

D_MODEL = 2048
BATCH = 4
SEQ = 4096
DEPTH = 2

D_RNN = D_MODEL // 2
RNN_HEADS = 8
RNN_HEAD_DIM = D_RNN // RNN_HEADS
CONV_WIDTH = 4
LRU_C = 8.0
D_SGU = D_MODEL // 2
SGU_GROUPS = 8
SGU_GROUP_DIM = D_SGU // SGU_GROUPS
CHUNK = 128
N_EXPERTS = 16
N_GROUPS = 4
EXPERTS_PER_GROUP = N_EXPERTS // N_GROUPS
TOP_K = 2
D_EXPERT = 1408
EXPERT_BLOCK = 256
D_IN = 2 * D_RNN + 2 * D_SGU + 2 * D_MODEL
SPLITS = (D_RNN, 2 * D_RNN, 2 * D_RNN + D_SGU, 2 * D_RNN + 2 * D_SGU, 2 * D_RNN + 2 * D_SGU + D_MODEL)
LN_EPS = 1e-5
DEEPNORM_ALPHA = (2 * DEPTH) ** 0.25
DEEPNORM_BETA = (8 * DEPTH) ** -0.25

kernel_name = "hybrid_rglru_sgu_grouped_moe_deepnorm"


def layer_norm(x, g, b):
    xf = x.astype(jnp.float32)
    mu = xf.mean(-1, keepdims=True)
    var = jnp.square(xf - mu).mean(-1, keepdims=True)
    y = (xf - mu) * lax.rsqrt(var + LN_EPS) * g.astype(jnp.float32) + b.astype(jnp.float32)
    return y.astype(x.dtype)


def causal_depthwise_conv(x, w, b):
    y = lax.conv_general_dilated(
        x, w[:, None, :].astype(x.dtype), window_strides=(1,),
        padding=[(CONV_WIDTH - 1, 0)], dimension_numbers=("NWC", "WIO", "NWC"),
        feature_group_count=x.shape[-1])
    return y + b


def rg_lru(x, w_a, b_a, w_x, b_x, lam):
    B, S, _ = x.shape
    xh = x.reshape(B, S, RNN_HEADS, RNN_HEAD_DIM)
    r = jax.nn.sigmoid(jnp.einsum("bshi,hij->bshj", xh, w_a) + b_a).reshape(B, S, D_RNN)
    i = jax.nn.sigmoid(jnp.einsum("bshi,hij->bshj", xh, w_x) + b_x).reshape(B, S, D_RNN)
    log_a = -LRU_C * r.astype(jnp.float32) * jax.nn.softplus(-lam.astype(jnp.float32))
    a = jnp.exp(log_a)
    mult = jnp.sqrt(-jnp.expm1(2.0 * log_a))
    u = mult * (i * x).astype(jnp.float32)

    def combine(c1, c2):
        a1, b1 = c1
        a2, b2 = c2
        return a1 * a2, a2 * b1 + b2

    _, h = lax.associative_scan(combine, (a, u), axis=1)
    return h.astype(x.dtype)


def spatial_gating(u, v, ln_g, ln_b, w_s, b_s):
    B, S, _ = v.shape
    v = layer_norm(v, ln_g, ln_b)
    vc = v.reshape(B, S // CHUNK, CHUNK, SGU_GROUPS, SGU_GROUP_DIM)
    causal = jnp.tril(jnp.ones((CHUNK, CHUNK), dtype=bool))
    ws = jnp.where(causal, w_s, 0)
    mixed = jnp.einsum("gts,bcsgd->bctgd", ws, vc) + b_s.T[:, :, None]
    return u * mixed.reshape(B, S, D_SGU)


def hybrid_mixer(x, w_in, conv_w, conv_b, lru_w_a, lru_b_a, lru_w_x, lru_b_x, lru_lambda,
                 w_o_rnn, sgu_ln_g, sgu_ln_b, sgu_w_s, sgu_b_s, w_o_sgu, w_out):
    proj = x @ w_in
    x_rnn, gate_rnn, z_u, z_v, g_a, g_b = jnp.split(proj, SPLITS, axis=-1)
    h = rg_lru(causal_depthwise_conv(x_rnn, conv_w, conv_b), lru_w_a, lru_b_a, lru_w_x, lru_b_x, lru_lambda)
    y_a = (h * jax.nn.gelu(gate_rnn)) @ w_o_rnn
    y_b = spatial_gating(jax.nn.gelu(z_u), jax.nn.gelu(z_v), sgu_ln_g, sgu_ln_b, sgu_w_s, sgu_b_s) @ w_o_sgu
    merged = jax.nn.sigmoid(g_a) * y_a + jax.nn.sigmoid(g_b) * y_b
    return merged @ w_out


def route(x_flat, router_w, router_b):
    T = x_flat.shape[0]
    scores = jax.nn.softmax((x_flat @ router_w).astype(jnp.float32), axis=-1)
    sel = scores + router_b.astype(jnp.float32)
    grp_score = lax.top_k(sel.reshape(T, N_GROUPS, EXPERTS_PER_GROUP), TOP_K)[0].sum(-1)
    best = jnp.argmax(grp_score, axis=-1)
    in_group = (jnp.arange(N_EXPERTS) // EXPERTS_PER_GROUP)[None, :] == best[:, None]
    _, idx = lax.top_k(jnp.where(in_group, sel, -jnp.inf), TOP_K)
    w = jnp.take_along_axis(scores, idx, axis=-1)
    w = w / w.sum(-1, keepdims=True)
    return idx.astype(jnp.int32), w


def moe(x, router_w, router_b, w1, w3, w2):
    B, S, D = x.shape
    T = B * S
    A = T * TOP_K
    xf = x.reshape(T, D)
    idx, gate = route(xf, router_w, router_b)
    flat_e = idx.reshape(A)
    flat_tok = jnp.repeat(jnp.arange(T, dtype=jnp.int32), TOP_K)
    order = jnp.argsort(flat_e)
    e_sorted = flat_e[order]
    tok_sorted = flat_tok[order]
    w_sorted = gate.reshape(A)[order]
    counts = jnp.zeros((N_EXPERTS,), jnp.int32).at[flat_e].add(1)
    start = jnp.cumsum(counts) - counts
    padded = (counts + EXPERT_BLOCK - 1) // EXPERT_BLOCK * EXPERT_BLOCK
    pad_end = jnp.cumsum(padded)
    pad_start = pad_end - padded
    dest = pad_start[e_sorted] + jnp.arange(A, dtype=jnp.int32) - start[e_sorted]
    n_blocks = -(-A // EXPERT_BLOCK) + N_EXPERTS
    P = n_blocks * EXPERT_BLOCK
    buf_tok = jnp.full((P,), T, jnp.int32).at[dest].set(tok_sorted)
    x_ext = jnp.concatenate([xf, jnp.zeros((1, D), xf.dtype)], axis=0)
    xb = x_ext[buf_tok].reshape(n_blocks, EXPERT_BLOCK, D)
    block_e = jnp.minimum(
        jnp.searchsorted(pad_end, jnp.arange(n_blocks, dtype=jnp.int32) * EXPERT_BLOCK, side="right"),
        N_EXPERTS - 1)

    def expert_block(args):
        xblk, e = args
        hdn = jax.nn.silu(xblk @ w1[e]) * (xblk @ w3[e])
        return hdn @ w2[e]

    yb = lax.map(expert_block, (xb, block_e)).reshape(P, D)
    y = jnp.zeros((T, D), x.dtype).at[tok_sorted].add(yb[dest] * w_sorted[:, None].astype(x.dtype))
    return y.reshape(B, S, D)


def setup_inputs(seed: int = 0) -> dict:
    key = jax.random.key(seed)
    ks = jax.random.split(key, 32)
    L, D = DEPTH, D_MODEL
    f32 = jnp.float32

    def nrm(k, shape, scale):
        return jax.random.normal(k, shape, f32) * scale

    u = jax.random.uniform(ks[9], (L, D_RNN), f32, minval=0.9, maxval=0.999)
    s = u ** (1.0 / LRU_C)
    lru_lambda = jnp.log(s) - jnp.log1p(-s)
    return {
        "x": nrm(ks[0], (BATCH, SEQ, D), 1.0),
        "emb_ln_g": 1.0 + nrm(ks[1], (D,), 0.02),
        "emb_ln_b": nrm(ks[2], (D,), 0.02),
        "w_in": nrm(ks[3], (L, D, D_IN), D ** -0.5),
        "conv_w": nrm(ks[4], (L, CONV_WIDTH, D_RNN), CONV_WIDTH ** -0.5),
        "conv_b": nrm(ks[5], (L, D_RNN), 0.02),
        "lru_w_a": nrm(ks[6], (L, RNN_HEADS, RNN_HEAD_DIM, RNN_HEAD_DIM), RNN_HEAD_DIM ** -0.5),
        "lru_b_a": nrm(ks[7], (L, RNN_HEADS, RNN_HEAD_DIM), 0.02),
        "lru_w_x": nrm(ks[8], (L, RNN_HEADS, RNN_HEAD_DIM, RNN_HEAD_DIM), RNN_HEAD_DIM ** -0.5),
        "lru_b_x": nrm(ks[10], (L, RNN_HEADS, RNN_HEAD_DIM), 0.02),
        "lru_lambda": lru_lambda,
        "w_o_rnn": nrm(ks[11], (L, D_RNN, D), D_RNN ** -0.5),
        "sgu_ln_g": 1.0 + nrm(ks[12], (L, D_SGU), 0.02),
        "sgu_ln_b": nrm(ks[13], (L, D_SGU), 0.02),
        "sgu_w_s": nrm(ks[14], (L, SGU_GROUPS, CHUNK, CHUNK), CHUNK ** -0.5),
        "sgu_b_s": 1.0 + nrm(ks[15], (L, SGU_GROUPS, CHUNK), 0.1),
        "w_o_sgu": nrm(ks[16], (L, D_SGU, D), D_SGU ** -0.5),
        "w_out": nrm(ks[17], (L, D, D), D ** -0.5 * DEEPNORM_BETA),
        "ln1_g": 1.0 + nrm(ks[18], (L, D), 0.02),
        "ln1_b": nrm(ks[19], (L, D), 0.02),
        "router_w": nrm(ks[20], (D, N_EXPERTS), D ** -0.5),
        "router_b": nrm(ks[21], (N_EXPERTS,), 0.01),
        "expert_w1": nrm(ks[22], (L, N_EXPERTS, D, D_EXPERT), D ** -0.5),
        "expert_w3": nrm(ks[23], (L, N_EXPERTS, D, D_EXPERT), D ** -0.5),
        "expert_w2": nrm(ks[24], (L, N_EXPERTS, D_EXPERT, D), D_EXPERT ** -0.5 * DEEPNORM_BETA),
        "ln2_g": 1.0 + nrm(ks[25], (L, D), 0.02),
        "ln2_b": nrm(ks[26], (L, D), 0.02),
    }


def reference(x, emb_ln_g, emb_ln_b, w_in, conv_w, conv_b, lru_w_a, lru_b_a, lru_w_x, lru_b_x,
              lru_lambda, w_o_rnn, sgu_ln_g, sgu_ln_b, sgu_w_s, sgu_b_s, w_o_sgu, w_out,
              ln1_g, ln1_b, router_w, router_b, expert_w1, expert_w3, expert_w2, ln2_g, ln2_b):
    x = layer_norm(x, emb_ln_g, emb_ln_b)
    for l in range(DEPTH):
        m = hybrid_mixer(x, w_in[l], conv_w[l], conv_b[l], lru_w_a[l], lru_b_a[l], lru_w_x[l],
                         lru_b_x[l], lru_lambda[l], w_o_rnn[l], sgu_ln_g[l], sgu_ln_b[l],
                         sgu_w_s[l], sgu_b_s[l], w_o_sgu[l], w_out[l])
        x = layer_norm(DEEPNORM_ALPHA * x + m, ln1_g[l], ln1_b[l])
        f = moe(x, router_w, router_b, expert_w1[l], expert_w3[l], expert_w2[l])
        x = layer_norm(DEEPNORM_ALPHA * x + f, ln2_g[l], ln2_b[l])
    return x
```

```cpp
#include <hip/hip_runtime.h>
#include <cstdio>
#include <cstdint>

#ifndef MK_N_LAUNCHES
#define MK_N_LAUNCHES 1
#define PROJ_R2 1
#define CV_DEPTH 3
#endif

#define LAS __attribute__((address_space(3)))
#define GAS __attribute__((address_space(1)))
typedef unsigned short bf16;
typedef short bf16x8 __attribute__((ext_vector_type(8)));
typedef float f32x4 __attribute__((ext_vector_type(4)));
typedef float f32x2 __attribute__((ext_vector_type(2)));
typedef unsigned u32x4 __attribute__((ext_vector_type(4)));
typedef unsigned u32x2 __attribute__((ext_vector_type(2)));
#define RLX_AGENT __ATOMIC_RELAXED, __HIP_MEMORY_SCOPE_AGENT
#define LDS_WAIT() asm volatile("s_waitcnt lgkmcnt(0)" ::: "memory")
#define VM_WAIT() asm volatile("s_waitcnt vmcnt(0)" ::: "memory")

constexpr int T = 16384, SEQ = 4096, NB = 4, D = 2048, DIN = 8192, DR = 1024, NH = 8, HD = 128, NE = 16, DE = 1408, DEPTH = 2;
constexpr int NGRP = 4, CAP = 16384;
constexpr float ALPHA = 1.41421356237309515f;
constexpr float LN_EPS = 1e-5f;
constexpr int NWAVES = 8;
constexpr int PROWS = 36864;
constexpr int DEP = 1536;
#ifndef PROJ_F8
#define PROJ_F8 1
#endif
#ifndef PROJ_WGM
#define PROJ_WGM 4
#endif
#ifndef MIX_WGM
#define MIX_WGM 4
#endif
#ifndef MOE_WGM
#define MOE_WGM 2
#endif
#ifndef MIX_F8
#define MIX_F8 1
#endif
constexpr float HS_SCALE = 8.f, MG_SCALE = 8.f, WMIX_SCALE = 64.f;
constexpr float WIN_SCALE = 64.f;
constexpr float W13_SCALE = 64.f, W2_SCALE = 64.f, HDN_SCALE = 8.f, YS_SCALE = 16.f;

constexpr size_t MiB = 1u << 20;
constexpr size_t WS_CTL = 0, CTL_ZERO_BYTES = 1 * MiB;
constexpr size_t WS_AGG = 1 * MiB;
constexpr size_t WS_ZSTAT = WS_AGG + 512 * 1024;
constexpr size_t WS_TOKSLOT = WS_ZSTAT + 128 * 1024;
constexpr size_t WS_SP = WS_TOKSLOT + 128 * 1024;
constexpr size_t WS_LTOK = 2 * MiB;
constexpr size_t WS_LGATE = 3 * MiB;
constexpr size_t WS_WA = 4 * MiB;
constexpr size_t WS_WX = WS_WA + 512 * 1024;
constexpr size_t WS_WS = 5 * MiB;
constexpr size_t WS_WIN = 8 * MiB;
constexpr size_t WS_WCAT = 72 * MiB;
constexpr size_t WS_WOUT = 88 * MiB;
constexpr size_t WS_W13 = 104 * MiB;
constexpr size_t WS_W2 = 456 * MiB;
constexpr size_t WS_XN = 632 * MiB;
constexpr size_t WS_MERGED = 696 * MiB;
constexpr size_t WS_PROJ = 760 * MiB;
constexpr size_t WS_HDN = 760 * MiB;
constexpr size_t WS_X8 = WS_MERGED;
constexpr size_t WS_YS = 864 * MiB;
constexpr size_t WS_HS8 = 1016 * MiB;
constexpr size_t WS_END = 1048 * MiB;
static_assert(WIN_SCALE == 64.f && W13_SCALE == 64.f && W2_SCALE == 64.f, "the fp8 weight scale lives in the prologue's selection matrix");
static_assert(WS_HDN + (size_t)PROWS * DEP <= WS_YS && WS_YS + (size_t)PROWS * D * 2 <= WS_HS8, "ws map");
constexpr int CW_BAR = 4096;
constexpr int CW_CNT = 16384;
constexpr int CW_FLAG = 32768;
constexpr int CW_TMO = 8;

constexpr int RING_BYTES = 131072;
constexpr int X_OFF = RING_BYTES;
constexpr int X_AGGW = X_OFF;
constexpr int X_CW = X_OFF + 8192;
constexpr int X_TAB = X_OFF + 12288;
constexpr int X_MISC = X_OFF + 13312;
constexpr int LDS_BYTES = X_OFF + 16384;

__device__ __forceinline__ unsigned cvt_pk_bf16(float lo, float hi) { unsigned r; asm volatile("v_cvt_pk_bf16_f32 %0, %1, %2" : "=v"(r) : "v"(lo), "v"(hi)); return r; }
__device__ __forceinline__ unsigned cvt4_fp8(float a, float b, float c, float d) { int w = __builtin_amdgcn_cvt_pk_fp8_f32(a, b, 0, false); w = __builtin_amdgcn_cvt_pk_fp8_f32(c, d, w, true); return (unsigned)w; }
__device__ __forceinline__ float clamp448(float x) { return __builtin_amdgcn_fmed3f(x, -448.f, 448.f); }
__device__ __forceinline__ unsigned pk_u8(float a, float b, float c, float d) { return __builtin_amdgcn_cvt_pk_u8_f32(d + 0.5f, 3, __builtin_amdgcn_cvt_pk_u8_f32(c + 0.5f, 2, __builtin_amdgcn_cvt_pk_u8_f32(b + 0.5f, 1, __builtin_amdgcn_cvt_pk_u8_f32(a + 0.5f, 0, 0u)))); }
__device__ __forceinline__ void unpack_u8x8(const u32x2 w, float (&o)[8]) { o[0] = (float)(w.x & 255u); o[1] = (float)((w.x >> 8) & 255u); o[2] = (float)((w.x >> 16) & 255u); o[3] = (float)(w.x >> 24); o[4] = (float)(w.y & 255u); o[5] = (float)((w.y >> 8) & 255u); o[6] = (float)((w.y >> 16) & 255u); o[7] = (float)(w.y >> 24); }
__device__ __forceinline__ float bf_lo(unsigned u) { return __uint_as_float(u << 16); }
__device__ __forceinline__ float bf_hi(unsigned u) { return __uint_as_float(u & 0xffff0000u); }
__device__ __forceinline__ void unpack8(const u32x4 w, float (&o)[8]) { o[0] = bf_lo(w.x); o[1] = bf_hi(w.x); o[2] = bf_lo(w.y); o[3] = bf_hi(w.y); o[4] = bf_lo(w.z); o[5] = bf_hi(w.z); o[6] = bf_lo(w.w); o[7] = bf_hi(w.w); }
__device__ __forceinline__ u32x4 pack8(const float (&v)[8]) { u32x4 w; w.x = cvt_pk_bf16(v[0], v[1]); w.y = cvt_pk_bf16(v[2], v[3]); w.z = cvt_pk_bf16(v[4], v[5]); w.w = cvt_pk_bf16(v[6], v[7]); return w; }
__device__ __forceinline__ float fast_sigmoid(float z) { return __builtin_amdgcn_rcpf(1.0f + __builtin_amdgcn_exp2f(-1.44269504089f * z)); }
__device__ __forceinline__ float gelu_tanh(float x) { return x * fast_sigmoid(1.5957691216f * (x + 0.044715f * x * x * x)); }
template <int CTRL, int RMASK> __device__ __forceinline__ float dpp_mov0(float v) {
    return __builtin_bit_cast(float, __builtin_amdgcn_update_dpp(0, __builtin_bit_cast(int, v), CTRL, RMASK, 0xF, false));
}
__device__ __forceinline__ float wave_sum(float v) {
    v += dpp_mov0<0xB1, 0xF>(v);
    v += dpp_mov0<0x4E, 0xF>(v);
    v += dpp_mov0<0x124, 0xF>(v);
    v += dpp_mov0<0x128, 0xF>(v);
    v += dpp_mov0<0x142, 0xA>(v);
    v += dpp_mov0<0x143, 0xC>(v);
    return __builtin_bit_cast(float, __builtin_amdgcn_readlane(__builtin_bit_cast(int, v), 63));
}

typedef __amdgpu_buffer_rsrc_t rsrc_t;
__device__ __forceinline__ rsrc_t mk_rsrc_n(const void* p, int n) { return __builtin_amdgcn_make_buffer_rsrc((void*)p, 0, n, 0x00020000); }
__device__ __forceinline__ rsrc_t mk_rsrc(const void* p) { return __builtin_amdgcn_make_buffer_rsrc((void*)p, 0, 0x7fffffff, 0x00020000); }
__device__ __forceinline__ u32x4 bld128(rsrc_t r, unsigned voff, unsigned soff) { return __builtin_bit_cast(u32x4, __builtin_amdgcn_raw_buffer_load_b128(r, (int)(voff + soff), 0, 0)); }
__device__ __forceinline__ void bst128(u32x4 v, rsrc_t r, unsigned voff, unsigned soff) { __builtin_amdgcn_raw_buffer_store_b128(v, r, (int)(voff + soff), 0, 0); }
__device__ __forceinline__ unsigned uni(unsigned x) { return (unsigned)__builtin_amdgcn_readfirstlane((int)x); }
__device__ __forceinline__ u32x2 bld64(rsrc_t r, unsigned voff, unsigned soff) { return __builtin_bit_cast(u32x2, __builtin_amdgcn_raw_buffer_load_b64(r, (int)(voff + soff), 0, 0)); }
__device__ __forceinline__ void bst64(u32x2 v, rsrc_t r, unsigned voff, unsigned soff) { __builtin_amdgcn_raw_buffer_store_b64(v, r, (int)(voff + soff), 0, 0); }
__device__ __forceinline__ f32x4 bldf4(rsrc_t r, unsigned voff, unsigned soff) { return __builtin_bit_cast(f32x4, bld128(r, voff, soff)); }

namespace pg8 {
constexpr int BM = 256, BK = 64, HALF = 128, HTB = HALF * BK * 2, NXCD = 8, WGM = 4;
__host__ __device__ __forceinline__ int lds_byte(int r, int c) { const int st = (r >> 4) * 2 + (c >> 5), rr = r & 15, cc = c & 31, ob = rr * 64 + cc * 2; return st * 1024 + (ob ^ (((ob >> 9) & 1) << 5)); }
__host__ __device__ __forceinline__ void stage_rc(int b, int& R, int& C) { const int st = b / 1024, sb = b % 1024, swz = sb ^ (((sb >> 9) & 1) << 5); R = (st >> 1) * 16 + swz / 64; C = (st & 1) * 32 + (swz % 64) / 2; }
__host__ __device__ __forceinline__ int perm32(int rho) { const int n = rho >> 4, i = rho & 15; return 8 * (i >> 2) + 4 * n + (i & 3); }

typedef int i32x8 __attribute__((ext_vector_type(8)));
__device__ __forceinline__ i32x8 cat8(bf16x8 a, bf16x8 b) { typedef int i32x4_ __attribute__((ext_vector_type(4))); const i32x4_ x = __builtin_bit_cast(i32x4_, a), y = __builtin_bit_cast(i32x4_, b); return __builtin_shufflevector(x, y, 0, 1, 2, 3, 4, 5, 6, 7); }
__device__ __forceinline__ void mfma_f8z(f32x4& acc, i32x8 a, i32x8 b, int sc) { asm volatile("v_mfma_scale_f32_16x16x128_f8f6f4 %0, %1, %2, 0, %3, %3 op_sel_hi:[0,0,0]" : "=&v"(acc) : "v"(a), "v"(b), "v"(sc)); }
__device__ __forceinline__ void mfma_f8(f32x4& acc, i32x8 a, i32x8 b, int sc) { asm volatile("v_mfma_scale_f32_16x16x128_f8f6f4 %0, %1, %2, %0, %3, %3 op_sel_hi:[0,0,0]" : "+v"(acc) : "v"(a), "v"(b), "v"(sc)); }
struct Unit { const char* A; const char* B; int row0, pn, aux; };

__device__ __forceinline__ bool tile_of(int i, int G, int c, int nM, int nN, int& pm, int& pn, int wgm = WGM) {
    const int nwg = nM * nN; const long L = (long)i * G + c; if (L >= nwg) return false;
    int wgid = (int)L; { const int q = nwg / NXCD, r = nwg % NXCD, xcd = wgid % NXCD, off = wgid / NXCD; wgid = (xcd < r ? xcd * (q + 1) : r * (q + 1) + (xcd - r) * q) + off; }
    const int nig = wgm * nN, gid = wgid / nig, fm = gid * wgm, gsz = (nM - fm) < wgm ? (nM - fm) : wgm;
    pm = fm + ((wgid % nig) % gsz); pn = (wgid % nig) / gsz; return true;
}
struct RegOrder {
    static constexpr bool GATHER = false;
    const char* A; const char* Bt; int lda, K, nM, nN, G, c, esz; int wgm = WGM; int fold = 0; int imax = 1 << 30;
    __device__ __forceinline__ bool next(int i, Unit& u) const {
        int pm, pn; if (i >= imax || !tile_of(i, G, c, nM, nN, pm, pn, wgm)) return false;
        u.A = A + (size_t)(fold ? 0 : pm) * BM * lda * esz; u.B = Bt + (size_t)(fold ? 0 : pn) * BM * K * esz; u.row0 = pm * BM; u.pn = pn; u.aux = 0; return true;
    }
    __device__ __forceinline__ void voff(const Unit&, const int (&R)[2], const int (&C)[2], unsigned (&vo)[2][2]) const {
#pragma unroll
        for (int h = 0; h < 2; ++h)
#pragma unroll
            for (int i = 0; i < 2; ++i) vo[h][i] = (unsigned)((h * HALF + R[i]) * lda * esz) + (unsigned)C[i] * 2u;
    }
};
struct MoeOrder1 {
    static constexpr bool GATHER = true;
    const char* XN; const char* Bt; const int* list; const LAS int* tab; int nM, nN, G, c, wgm;
    __device__ __forceinline__ bool next(int i, Unit& u) const {
        int pm, pn; if (!tile_of(i, G, c, nM, nN, pm, pn, wgm)) return false;
        const int tv = __builtin_amdgcn_readfirstlane(tab[pm]), e = tv & 255, rt = tv >> 8;
        u.A = XN; u.B = Bt + (size_t)e * (2816u * 2048u) + (size_t)pn * BM * D; u.row0 = __builtin_amdgcn_readfirstlane(tab[160 + e]) + rt * BM; u.pn = pn; u.aux = tv; return true;
    }
    __device__ __forceinline__ void voff(const Unit& u, const int (&R)[2], const int (&C)[2], unsigned (&vo)[2][2]) const {
        const int e = u.aux & 255, rt = u.aux >> 8, cnt = __builtin_amdgcn_readfirstlane(tab[176 + e]);
#pragma unroll
        for (int h = 0; h < 2; ++h)
#pragma unroll
            for (int i = 0; i < 2; ++i) { int p = rt * BM + h * HALF + R[i]; p = p < cnt ? p : cnt - 1; const int tok = list[e * CAP + p]; vo[h][i] = (unsigned)tok * (unsigned)D + (unsigned)C[i] * 2u; }
    }
};
struct MoeOrder2 {
    static constexpr bool GATHER = false;
    const char* HDN; const char* Bt; const LAS int* tab; int nM, nN, G, c, wgm;
    __device__ __forceinline__ bool next(int i, Unit& u) const {
        int pm, pn; if (!tile_of(i, G, c, nM, nN, pm, pn, wgm)) return false;
        const int tv = __builtin_amdgcn_readfirstlane(tab[pm]), e = tv & 255, rt = tv >> 8;
        u.row0 = __builtin_amdgcn_readfirstlane(tab[160 + e]) + rt * BM; u.A = HDN + (size_t)u.row0 * DEP; u.B = Bt + (size_t)e * (2048u * (unsigned)DEP) + (size_t)pn * BM * DEP; u.pn = pn; u.aux = tv; return true;
    }
    __device__ __forceinline__ void voff(const Unit&, const int (&R)[2], const int (&C)[2], unsigned (&vo)[2][2]) const {
#pragma unroll
        for (int h = 0; h < 2; ++h)
#pragma unroll
            for (int i = 0; i < 2; ++i) vo[h][i] = (unsigned)((h * HALF + R[i]) * DEP) + (unsigned)C[i] * 2u;
    }
};

typedef f32x4 Acc[2][2][4][2];


__device__ __forceinline__ f32x2 sigm2_pre(f32x2 z) { f32x2 e; e.x = __builtin_amdgcn_exp2f(z.x); e.y = __builtin_amdgcn_exp2f(z.y); const f32x2 d = e + 1.0f; f32x2 r; r.x = __builtin_amdgcn_rcpf(d.x); r.y = __builtin_amdgcn_rcpf(d.y); return r; }
struct EpiProj {
    static constexpr bool PERM = true; static constexpr int MIDT = 0;
    bf16* O; float isc; bool dry = false;
    __device__ __forceinline__ void mid(Acc&, const Unit&, int, int, int, int) const {}
    template <int ACT> __device__ __forceinline__ void run(const Acc& acc, const Unit& u, int wr, int wc, int fr, int fq) const {
        const rsrc_t rO = mk_rsrc_n(O, dry ? 0 : 0x7fffffff);
        const unsigned loff = (unsigned)(fr * DIN + 8 * fq) * 2u;
        const float zs = -1.44269504089f * isc, c1 = -1.44269504089f * 1.5957691216f, c2 = c1 * 0.044715f;
#pragma unroll
        for (int ai = 0; ai < 2; ++ai)
#pragma unroll
            for (int m = 0; m < 4; ++m) { const unsigned so = uni(((unsigned)(u.row0 + wr * 64 + ai * HALF + m * 16) * DIN + u.pn * BM + wc * 32) * 2u);
#pragma unroll
                for (int bj = 0; bj < 2; ++bj) { f32x2 y[4];
#pragma unroll
                    for (int p = 0; p < 4; ++p) { const f32x4 a4 = acc[ai][bj][m][p >> 1]; const f32x2 a = (p & 1) ? (f32x2){a4[2], a4[3]} : (f32x2){a4[0], a4[1]};
                        if (ACT == 0) y[p] = a * isc;
                        else if (ACT == 1) { const f32x2 x = a * isc; const f32x2 t = x * x; const f32x2 uu = t * c2 + c1; y[p] = x * sigm2_pre(x * uu); }
                        else y[p] = sigm2_pre(a * zs) * 255.0f; }
                    if (ACT == 2) {
                        u32x2 w; w.x = pk_u8(y[0].x, y[0].y, y[1].x, y[1].y); w.y = pk_u8(y[2].x, y[2].y, y[3].x, y[3].y);
                        bst64(w, rO, (unsigned)(fr * DIN * 2 + 8 * fq), uni((unsigned)(u.row0 + wr * 64 + ai * HALF + m * 16) * (DIN * 2) + 8192u + (unsigned)(u.pn * BM - 4096 + wc * 32 + bj * HALF)));
                    } else {
                    u32x4 w; w.x = cvt_pk_bf16(y[0].x, y[0].y); w.y = cvt_pk_bf16(y[1].x, y[1].y); w.z = cvt_pk_bf16(y[2].x, y[2].y); w.w = cvt_pk_bf16(y[3].x, y[3].y);
                    bst128(w, rO, loff, so + bj * HALF * 2); } } }
    }
    __device__ __forceinline__ void operator()(const Acc& acc, const Unit& u, int wr, int wc, int fr, int fq) const {
        if (u.pn < 4) run<0>(acc, u, wr, wc, fr, fq); else if (u.pn < 16) run<1>(acc, u, wr, wc, fr, fq); else run<2>(acc, u, wr, wc, fr, fq);
    }
};
struct EpiYab {
    static constexpr bool PERM = true; static constexpr int MIDT = MIX_F8 ? 8 : 16;
    const bf16* P; bf16* O;
    __device__ __forceinline__ void mid(Acc& acc, const Unit& u, int wr, int wc, int fr, int fq) const {
        const rsrc_t rP = mk_rsrc(P);
        const unsigned loff = (unsigned)(fr * DIN * 2 + 8 * fq);
#pragma unroll
        for (int ai = 0; ai < 2; ++ai) { u32x2 ga[4][2], gb[4][2];
#pragma unroll
            for (int m = 0; m < 4; ++m) { const unsigned so = uni((unsigned)(u.row0 + wr * 64 + ai * HALF + m * 16) * (DIN * 2) + 8192u + (unsigned)(u.pn * BM + wc * 32));
#pragma unroll
                for (int bj = 0; bj < 2; ++bj) { ga[m][bj] = bld64(rP, loff, so + bj * HALF); gb[m][bj] = bld64(rP, loff, so + 2048 + bj * HALF); } }
#pragma unroll
            for (int m = 0; m < 4; ++m)
#pragma unroll
                for (int bj = 0; bj < 2; ++bj) { float a[8], g[8]; unpack_u8x8(ga[m][bj], a); unpack_u8x8(gb[m][bj], g);
#pragma unroll
                    for (int j = 0; j < 4; ++j) { acc[ai][bj][m][0][j] *= a[j] * __builtin_amdgcn_rcpf(g[j] + 1e-18f); acc[ai][bj][m][1][j] *= a[4 + j] * __builtin_amdgcn_rcpf(g[4 + j] + 1e-18f); } }
            asm volatile("" ::: "memory"); }
    }
    __device__ __forceinline__ void operator()(const Acc& acc, const Unit& u, int wr, int wc, int fr, int fq) const {
        const rsrc_t rP = mk_rsrc(P), rO = mk_rsrc(O);
        const unsigned loffP = (unsigned)(fr * DIN * 2 + 8 * fq), loffO = (unsigned)(fr * D + 8 * fq) * 2u;
        u32x2 gb[2][4][2];
#pragma unroll
        for (int ai = 0; ai < 2; ++ai)
#pragma unroll
            for (int m = 0; m < 4; ++m) { const unsigned soP = uni((unsigned)(u.row0 + wr * 64 + ai * HALF + m * 16) * (DIN * 2) + 8192u + 2048u + (unsigned)(u.pn * BM + wc * 32));
#pragma unroll
                for (int bj = 0; bj < 2; ++bj) gb[ai][m][bj] = bld64(rP, loffP, soP + bj * HALF); }
        constexpr float I255 = 1.0f / 255.0f;
#pragma unroll
        for (int ai = 0; ai < 2; ++ai)
#pragma unroll
            for (int m = 0; m < 4; ++m) { const unsigned soO = uni((((unsigned)(u.row0 + wr * 64 + ai * HALF + m * 16)) * D + u.pn * BM + wc * 32) * 2u);
#pragma unroll
                for (int bj = 0; bj < 2; ++bj) { float g[8]; unpack_u8x8(gb[ai][m][bj], g);
#pragma unroll
                    for (int j = 0; j < 8; ++j) g[j] = (g[j] + 1e-18f) * I255;
#if MIX_F8
                    { constexpr float OS = MG_SCALE / (HS_SCALE * WMIX_SCALE);
                      u32x2 w8; w8.x = cvt4_fp8(clamp448(acc[ai][bj][m][0][0] * g[0] * OS), clamp448(acc[ai][bj][m][0][1] * g[1] * OS), clamp448(acc[ai][bj][m][0][2] * g[2] * OS), clamp448(acc[ai][bj][m][0][3] * g[3] * OS));
                      w8.y = cvt4_fp8(clamp448(acc[ai][bj][m][1][0] * g[4] * OS), clamp448(acc[ai][bj][m][1][1] * g[5] * OS), clamp448(acc[ai][bj][m][1][2] * g[6] * OS), clamp448(acc[ai][bj][m][1][3] * g[7] * OS));
                      bst64(w8, rO, (unsigned)(fr * D + 8 * fq), uni((unsigned)(u.row0 + wr * 64 + ai * HALF + m * 16) * D + u.pn * BM + wc * 32) + bj * HALF); }
#else
                    u32x4 w; w.x = cvt_pk_bf16(acc[ai][bj][m][0][0] * g[0], acc[ai][bj][m][0][1] * g[1]); w.y = cvt_pk_bf16(acc[ai][bj][m][0][2] * g[2], acc[ai][bj][m][0][3] * g[3]);
                    w.z = cvt_pk_bf16(acc[ai][bj][m][1][0] * g[4], acc[ai][bj][m][1][1] * g[5]); w.w = cvt_pk_bf16(acc[ai][bj][m][1][2] * g[6], acc[ai][bj][m][1][3] * g[7]);
                    bst128(w, rO, loffO, soO + bj * HALF * 2);
#endif
                    } }
    }
};
struct EpiWout {
    static constexpr bool PERM = true; static constexpr int MIDT = 0;
    bf16* X; bool dry;
    __device__ __forceinline__ void mid(Acc&, const Unit&, int, int, int, int) const {}
    __device__ __forceinline__ void operator()(const Acc& acc, const Unit& u, int wr, int wc, int fr, int fq) const {
        constexpr float AS = MIX_F8 ? 1.0f / (MG_SCALE * WMIX_SCALE) : 1.0f;
        const rsrc_t rX = mk_rsrc(X); const rsrc_t rXst = mk_rsrc_n(X, dry ? 0 : 0x7fffffff);
        const unsigned loff = (unsigned)(fr * D + 8 * fq) * 2u;
#pragma unroll
        for (int ai = 0; ai < 2; ++ai) { u32x4 xr[4][2];
#pragma unroll
            for (int m = 0; m < 4; ++m) { const unsigned so = uni(((unsigned)(u.row0 + wr * 64 + ai * HALF + m * 16) * D + u.pn * BM + wc * 32) * 2u);
#pragma unroll
                for (int bj = 0; bj < 2; ++bj) xr[m][bj] = bld128(rX, loff, so + bj * HALF * 2); }
#pragma unroll
            for (int m = 0; m < 4; ++m) { const unsigned so = uni(((unsigned)(u.row0 + wr * 64 + ai * HALF + m * 16) * D + u.pn * BM + wc * 32) * 2u);
#pragma unroll
                for (int bj = 0; bj < 2; ++bj) { float xv[8]; unpack8(xr[m][bj], xv);
                    u32x4 w; w.x = cvt_pk_bf16(ALPHA * xv[0] + acc[ai][bj][m][0][0] * AS, ALPHA * xv[1] + acc[ai][bj][m][0][1] * AS); w.y = cvt_pk_bf16(ALPHA * xv[2] + acc[ai][bj][m][0][2] * AS, ALPHA * xv[3] + acc[ai][bj][m][0][3] * AS);
                    w.z = cvt_pk_bf16(ALPHA * xv[4] + acc[ai][bj][m][1][0] * AS, ALPHA * xv[5] + acc[ai][bj][m][1][1] * AS); w.w = cvt_pk_bf16(ALPHA * xv[6] + acc[ai][bj][m][1][2] * AS, ALPHA * xv[7] + acc[ai][bj][m][1][3] * AS);
                    bst128(w, rXst, loff, so + bj * HALF * 2); } }
            asm volatile("" ::: "memory"); }
    }
};
struct EpiMoe1 {
    static constexpr bool PERM = true; static constexpr int MIDT = 0;
    unsigned char* O;
    __device__ __forceinline__ void mid(Acc&, const Unit&, int, int, int, int) const {}
    __device__ __forceinline__ void operator()(const Acc& acc, const Unit& u, int wr, int wc, int fr, int fq) const {
        const rsrc_t rO = mk_rsrc(O);
        const unsigned loff = (unsigned)(fr * DEP + 8 * fq);
        constexpr float IS = 1.0f / W13_SCALE, ZS = -1.44269504089f * IS, OS = HDN_SCALE * IS * IS;
#pragma unroll
        for (int ai = 0; ai < 2; ++ai)
#pragma unroll
            for (int m = 0; m < 4; ++m) { f32x2 y[4];
#pragma unroll
                for (int p = 0; p < 4; ++p) { const f32x4 a4 = acc[ai][0][m][p >> 1], b4 = acc[ai][1][m][p >> 1];
                    const f32x2 a = (p & 1) ? (f32x2){a4[2], a4[3]} : (f32x2){a4[0], a4[1]}, b = (p & 1) ? (f32x2){b4[2], b4[3]} : (f32x2){b4[0], b4[1]};
                    const f32x2 v = (a * sigm2_pre(a * ZS)) * (b * OS); y[p].x = clamp448(v.x); y[p].y = clamp448(v.y); }
                u32x2 w; w.x = cvt4_fp8(y[0].x, y[0].y, y[1].x, y[1].y); w.y = cvt4_fp8(y[2].x, y[2].y, y[3].x, y[3].y);
                const unsigned so = uni((unsigned)(u.row0 + wr * 64 + ai * HALF + m * 16) * DEP + u.pn * HALF + wc * 32);
                bst64(w, rO, loff, so);
                if (u.pn == 10) { unsigned z; asm volatile("v_mov_b32 %0, 0" : "=v"(z)); bst64((u32x2){z, z}, rO, loff, so + HALF); } }
    }
};
struct EpiMoe2 {
    static constexpr bool PERM = true; static constexpr int MIDT = 0;
    unsigned char* O; const float* gl; const LAS int* tab;
    __device__ __forceinline__ void mid(Acc&, const Unit&, int, int, int, int) const {}
    __device__ __forceinline__ void operator()(const Acc& acc, const Unit& u, int wr, int wc, int fr, int fq) const {
        const rsrc_t rO = mk_rsrc(O);
        const int e = u.aux & 255, rt = u.aux >> 8, cnt = __builtin_amdgcn_readfirstlane(tab[176 + e]);
        const unsigned loff = (unsigned)(fr * D + 8 * fq);
#pragma unroll
        for (int ai = 0; ai < 2; ++ai)
#pragma unroll
            for (int m = 0; m < 4; ++m) { const int rlu = wr * 64 + ai * HALF + m * 16; int p = rt * BM + rlu + fr; p = p < cnt ? p : cnt - 1; const float g = gl[e * CAP + p] * (YS_SCALE / (HDN_SCALE * W2_SCALE));
                const unsigned so = uni((unsigned)(u.row0 + rlu) * D + u.pn * BM + wc * 32);
#pragma unroll
                for (int bj = 0; bj < 2; ++bj) { const f32x4 v0 = acc[ai][bj][m][0] * g, v1 = acc[ai][bj][m][1] * g;
                    u32x2 w; w.x = cvt4_fp8(clamp448(v0[0]), clamp448(v0[1]), clamp448(v0[2]), clamp448(v0[3])); w.y = cvt4_fp8(clamp448(v1[0]), clamp448(v1[1]), clamp448(v1[2]), clamp448(v1[3]));
                    bst64(w, rO, loff, so + bj * HALF); } }
    }
};

template <class Epi, class Sched, bool F8 = false, bool PADLAST = false>
__device__ __forceinline__ void gemm_phase(LAS unsigned char* lds, const int K, const Sched& S, const Epi& E, const int tid) {
    const int wid = __builtin_amdgcn_readfirstlane(tid >> 6), lane = tid & 63, wr = wid >> 2, wc = wid & 3, fr = lane & 15, fq = lane >> 4;
    const int nt = F8 ? K / 128 : K / BK; const int KB = F8 ? K : 2 * K;
    int R[2], C[2]; unsigned voffB[2];
#pragma unroll
    for (int i = 0; i < 2; ++i) { stage_rc(tid * 16 + i * 8192, R[i], C[i]); const int Rb = Epi::PERM ? ((R[i] & ~31) + perm32(R[i] & 31)) : R[i]; voffB[i] = (unsigned)(Rb * KB) + (unsigned)C[i] * 2u; }
    const size_t kstep = (size_t)(BK * 2);
    const size_t hstepB = (size_t)HALF * KB;
    const unsigned ldsw = (unsigned)wid * 1024u;
    const int aoff = lds_byte(wr * 64 + fr, fq * 8), boff = lds_byte(wc * 32 + fr, fq * 8);
#define PG8_SA(b, h) (((b) * 2 + (h)) * HTB)
#define PG8_SB(b, h) ((4 + (b) * 2 + (h)) * HTB)
#define PG8_STAGE(bufoff, gbase, voff) do { _Pragma("unroll") for (int _i = 0; _i < 2; ++_i) \
        __builtin_amdgcn_global_load_lds((const unsigned*)((const char*)(gbase) + (voff)[_i]), (LAS unsigned*)(lds + (bufoff) + ldsw + _i * 8192), 16, 0, 0); } while (0)
#define PG8_LDA(dst, b, h) do { _Pragma("unroll") for (int m = 0; m < 4; ++m) _Pragma("unroll") for (int k = 0; k < 2; ++k) dst[m][k] = *(const LAS bf16x8*)(lds + PG8_SA(b, h) + aoff + m * 2048 + k * 1024); } while (0)
#define PG8_LDB(dst, b, h) do { _Pragma("unroll") for (int n = 0; n < 2; ++n) _Pragma("unroll") for (int k = 0; k < 2; ++k) dst[n][k] = *(const LAS bf16x8*)(lds + PG8_SB(b, h) + boff + n * 2048 + k * 1024); } while (0)
#define PG8_MMA(ai, bj, At, Bt) do { __builtin_amdgcn_s_setprio(1); _Pragma("unroll") for (int m = 0; m < 4; ++m) _Pragma("unroll") for (int n = 0; n < 2; ++n) { \
        if constexpr (F8) mfma_f8(acc[ai][bj][m][n], cat8(Bt[n][0], Bt[n][1]), cat8(At[m][0], At[m][1]), sc1); \
        else { _Pragma("unroll") for (int k = 0; k < 2; ++k) acc[ai][bj][m][n] = __builtin_amdgcn_mfma_f32_16x16x32_bf16(Bt[n][k], At[m][k], acc[ai][bj][m][n], 0, 0, 0); } } __builtin_amdgcn_s_setprio(0); } while (0)
#define PG8_MMAZ(ai, bj, At, Bt) do { __builtin_amdgcn_s_setprio(1); _Pragma("unroll") for (int m = 0; m < 4; ++m) _Pragma("unroll") for (int n = 0; n < 2; ++n) { \
        if constexpr (F8) mfma_f8z(acc[ai][bj][m][n], cat8(Bt[n][0], Bt[n][1]), cat8(At[m][0], At[m][1]), sc1); \
        else { acc[ai][bj][m][n] = __builtin_amdgcn_mfma_f32_16x16x32_bf16(Bt[n][0], At[m][0], (f32x4){0.f, 0.f, 0.f, 0.f}, 0, 0, 0); acc[ai][bj][m][n] = __builtin_amdgcn_mfma_f32_16x16x32_bf16(Bt[n][1], At[m][1], acc[ai][bj][m][n], 0, 0, 0); } } __builtin_amdgcn_s_setprio(0); } while (0)
#define PG8_WAIT_V(n) asm volatile("s_waitcnt vmcnt(" #n ")" ::: "memory")
#define PG8_WAIT_L(n) asm volatile("s_waitcnt lgkmcnt(" #n ")" ::: "memory")
#define PG8_BAR __builtin_amdgcn_s_barrier()
#define PG8_SCHED __builtin_amdgcn_sched_barrier(0)
    Unit cur, nxt; int ui = 0;
    if (!S.next(0, cur)) return;
    int sc1 = 0x7f7f7f7f; asm volatile("" : "+v"(sc1));
    unsigned va[2][2], vn[2][2];
    S.voff(cur, R, C, va);
    Acc acc;
    bf16x8 At[4][2], B0[2][2], B1[2][2];
    const char* cA = cur.A; const char* cB = cur.B;
    PG8_STAGE(PG8_SB(0, 0), cB, voffB); PG8_STAGE(PG8_SB(0, 1), cB + hstepB, voffB); PG8_STAGE(PG8_SA(0, 0), cA, va[0]); PG8_STAGE(PG8_SA(0, 1), cA, va[1]);
    if (wr == 1) PG8_BAR;
    PG8_WAIT_V(2); PG8_BAR;
    PG8_STAGE(PG8_SB(1, 0), cB + kstep, voffB); PG8_STAGE(PG8_SA(1, 0), cA + kstep, va[0]); PG8_STAGE(PG8_SB(1, 1), cB + hstepB + kstep, voffB);
    PG8_WAIT_V(6); PG8_BAR;
    for (;;) {
        const bool has_next = S.next(ui + 1, nxt);
        if (Sched::GATHER && has_next) S.voff(nxt, R, C, vn);
        else {
#pragma unroll
            for (int h = 0; h < 2; ++h)
#pragma unroll
                for (int i = 0; i < 2; ++i) vn[h][i] = va[h][i]; }
        const char* nA = has_next ? nxt.A : cA; const char* nB = has_next ? nxt.B : cB;
        for (int t = 0; t < nt; t += 2) {
            const bool last = (t == nt - 2);
            const char* a1 = cA + (size_t)(t + 1) * kstep;
            const char* a2 = last ? nA : cA + (size_t)(t + 2) * kstep; const char* b2 = last ? nB : cB + (size_t)(t + 2) * kstep;
            const char* a3 = a2 + kstep; const char* b3 = b2 + kstep;
            unsigned v2[2][2];
#pragma unroll
            for (int h = 0; h < 2; ++h)
#pragma unroll
                for (int i = 0; i < 2; ++i) v2[h][i] = (Sched::GATHER && last) ? vn[h][i] : va[h][i];
            if constexpr (Epi::MIDT > 0) { if (t == Epi::MIDT) E.mid(acc, cur, wr, wc, fr, fq); }
            PG8_LDB(B0, 0, 0); PG8_LDB(B1, 0, 1); PG8_SCHED; PG8_LDA(At, 0, 0); PG8_STAGE(PG8_SA(1, 1), a1, va[1]);
            PG8_WAIT_V(8); PG8_WAIT_L(0); PG8_BAR; if (t == 0) { PG8_MMAZ(0, 0, At, B0); PG8_MMAZ(0, 1, At, B1); } else { PG8_MMA(0, 0, At, B0); PG8_MMA(0, 1, At, B1); } PG8_BAR; PG8_SCHED;
            PG8_LDA(At, 0, 1); PG8_STAGE(PG8_SB(0, 0), b2, voffB); PG8_STAGE(PG8_SB(0, 1), b2 + hstepB, voffB); PG8_STAGE(PG8_SA(0, 0), a2, v2[0]);
            PG8_WAIT_V(8); PG8_WAIT_L(0); PG8_BAR; if (t == 0) { PG8_MMAZ(1, 0, At, B0); PG8_MMAZ(1, 1, At, B1); } else { PG8_MMA(1, 0, At, B0); PG8_MMA(1, 1, At, B1); } PG8_BAR; PG8_SCHED;
            const bool skip = PADLAST && last;
            if (!skip) { PG8_LDB(B0, 1, 0); PG8_LDB(B1, 1, 1); PG8_SCHED; PG8_LDA(At, 1, 0); } PG8_STAGE(PG8_SA(0, 1), a2, v2[1]);
            PG8_WAIT_V(8); PG8_WAIT_L(0); PG8_BAR; if (!skip) { PG8_MMA(0, 0, At, B0); PG8_MMA(0, 1, At, B1); } PG8_BAR; PG8_SCHED;
            if (!skip) { PG8_LDA(At, 1, 1); } PG8_STAGE(PG8_SB(1, 0), b3, voffB); PG8_STAGE(PG8_SB(1, 1), b3 + hstepB, voffB); PG8_STAGE(PG8_SA(1, 0), a3, v2[0]);
            PG8_WAIT_V(8); PG8_WAIT_L(0); PG8_BAR; if (!skip) { PG8_MMA(1, 0, At, B0); PG8_MMA(1, 1, At, B1); } PG8_BAR; PG8_SCHED;
        }
        if (wr == 0) PG8_BAR;
        if constexpr (F8) asm volatile("s_nop 15\n\ts_nop 15" ::: "memory");
        E(acc, cur, wr, wc, fr, fq);
        if (!has_next) break;
        cur = nxt; cA = nA; cB = nB; ++ui;
#pragma unroll
        for (int h = 0; h < 2; ++h)
#pragma unroll
            for (int i = 0; i < 2; ++i) va[h][i] = vn[h][i];
        if (wr == 1) PG8_BAR;
    }
    PG8_WAIT_V(0);
    PG8_BAR;
#undef PG8_SA
#undef PG8_SB
#undef PG8_STAGE
#undef PG8_LDA
#undef PG8_LDB
#undef PG8_MMA
#undef PG8_WAIT_V
#undef PG8_WAIT_L
#undef PG8_BAR
#undef PG8_SCHED
}
}

#define XB_TMO      128
#define XB_XCNT(j)  (256  + 64 * (j))
#define XB_XSUB(j)  (1280 + 64 * (j))
#define XB_XGEN(j)  (2304 + 64 * (j))
#define XB_TOP      3328
#define XB_TOPGEN   3392
#define XCD_BAR_WORDS 3456
#define XB_SPIN_CAP (1u << 22)
__device__ __forceinline__ unsigned xb_ld(unsigned* p)              { return __hip_atomic_load(p, __ATOMIC_RELAXED, __HIP_MEMORY_SCOPE_AGENT); }
__device__ __forceinline__ unsigned xb_add(unsigned* p, unsigned v) { return __hip_atomic_fetch_add(p, v, __ATOMIC_RELAXED, __HIP_MEMORY_SCOPE_AGENT); }
__device__ __forceinline__ unsigned xb_xcc_id() { return (unsigned)__builtin_amdgcn_s_getreg((3 << 11) | 20) & 0xFu; }
#define XB_SPIN(cond, bar) do { unsigned _sp = 0; while (cond) { __builtin_amdgcn_s_sleep(1); \
    if ((++_sp & 255u) == 0u) { if (xb_ld(&(bar)[XB_TMO])) break; if (_sp > XB_SPIN_CAP) { atomicAdd(&(bar)[XB_TMO], 1u); break; } } } } while (0)
struct XcdBarrier { unsigned* bar; unsigned x; volatile LAS unsigned* st; };
__device__ __forceinline__ XcdBarrier xcd_barrier_post(unsigned* bar, volatile LAS unsigned* st) {
    XcdBarrier b; b.bar = bar; b.x = xb_xcc_id(); b.st = st;
    if (threadIdx.x == 0) (void)xb_add(&bar[XB_XCNT(b.x)], 1u);
    return b;
}
__device__ __forceinline__ void xcd_barrier_complete(unsigned* bar, unsigned x, unsigned& nloc, unsigned& nx) {
    const unsigned G = gridDim.x * gridDim.y * gridDim.z;
    unsigned sum, cnt, mine, sp = 0u;
    for (;;) {
        sum = 0u; cnt = 0u; mine = 0u;
#pragma unroll
        for (unsigned j = 0; j < 16; ++j) { const unsigned c = xb_ld(&bar[XB_XCNT(j)]); sum += c; cnt += (c > 0u) ? 1u : 0u; mine = (j == x) ? c : mine; }
        if (sum == G) break;
        __builtin_amdgcn_s_sleep(1);
        if ((++sp & 255u) == 0u) { if (xb_ld(&bar[XB_TMO])) break; if (sp > XB_SPIN_CAP) { atomicAdd(&bar[XB_TMO], 1u); break; } }
    }
    nloc = mine > 0u ? mine : 1u; nx = cnt > 0u ? cnt : 1u;
}
__device__ __forceinline__ void xcd_barrier(const XcdBarrier& b) {
    asm volatile("s_waitcnt vmcnt(0)" ::: "memory");
    __syncthreads();
    if (threadIdx.x == 0) {
        unsigned* bar = b.bar;
        __builtin_amdgcn_s_waitcnt(0);
        unsigned nloc = b.st[0], nx = b.st[1];
        if (nloc == 0u) { xcd_barrier_complete(bar, b.x, nloc, nx); b.st[0] = nloc; b.st[1] = nx; }
        const unsigned old = xb_add(&bar[XB_XSUB(b.x)], 1u);
        const unsigned gen = old / nloc;
        if (old + 1u == (gen + 1u) * nloc) {
            __builtin_amdgcn_fence(__ATOMIC_RELEASE, "agent");
            asm volatile("s_waitcnt vmcnt(0)" ::: "memory");
            const unsigned og = xb_add(&bar[XB_TOP], 1u);
            const unsigned tg = og / nx;
            if (og + 1u == (tg + 1u) * nx) xb_add(&bar[XB_TOPGEN], 1u);
            else XB_SPIN(xb_ld(&bar[XB_TOPGEN]) == tg, bar);
            xb_add(&bar[XB_XGEN(b.x)], 1u);
            asm volatile("buffer_inv sc1\n\ts_waitcnt vmcnt(0)" ::: "memory");
        } else {
            XB_SPIN(xb_ld(&bar[XB_XGEN(b.x)]) == gen, bar);
            __builtin_amdgcn_fence(__ATOMIC_ACQUIRE, "agent");
            asm volatile("s_waitcnt vmcnt(0)" ::: "memory");
        }
    }
    __syncthreads();
}

__device__ __forceinline__ void ln_row32(float (&v)[4][8], const float* g, const float* b, int lane) {
    float s = 0.f;
#pragma unroll
    for (int j = 0; j < 4; ++j)
#pragma unroll
        for (int i = 0; i < 8; ++i) s += v[j][i];
    const float mean = wave_sum(s) * (1.f / D); float s2 = 0.f;
#pragma unroll
    for (int j = 0; j < 4; ++j)
#pragma unroll
        for (int i = 0; i < 8; ++i) { v[j][i] -= mean; s2 += v[j][i] * v[j][i]; }
    const float rstd = 1.f / sqrtf(wave_sum(s2) * (1.f / D) + LN_EPS);
#pragma unroll
    for (int j = 0; j < 4; ++j) { const f32x4 g0 = *(const f32x4*)(g + 8 * lane + 512 * j), g1 = *(const f32x4*)(g + 8 * lane + 512 * j + 4), b0 = *(const f32x4*)(b + 8 * lane + 512 * j), b1 = *(const f32x4*)(b + 8 * lane + 512 * j + 4);
#pragma unroll
        for (int i = 0; i < 4; ++i) { v[j][i] = v[j][i] * rstd * g0[i] + b0[i]; v[j][4 + i] = v[j][4 + i] * rstd * g1[i] + b1[i]; } }
}
__device__ __forceinline__ void ln_row32(float (&v)[4][8], const LAS float* g, const LAS float* b, int lane) {
    float s = 0.f;
#pragma unroll
    for (int j = 0; j < 4; ++j)
#pragma unroll
        for (int i = 0; i < 8; ++i) s += v[j][i];
    const float mean = wave_sum(s) * (1.f / D); float s2 = 0.f;
#pragma unroll
    for (int j = 0; j < 4; ++j)
#pragma unroll
        for (int i = 0; i < 8; ++i) { v[j][i] -= mean; s2 += v[j][i] * v[j][i]; }
    const float rstd = 1.f / sqrtf(wave_sum(s2) * (1.f / D) + LN_EPS);
#pragma unroll
    for (int j = 0; j < 4; ++j) { const f32x4 g0 = *(const LAS f32x4*)(g + 8 * lane + 512 * j), g1 = *(const LAS f32x4*)(g + 8 * lane + 512 * j + 4), b0 = *(const LAS f32x4*)(b + 8 * lane + 512 * j), b1 = *(const LAS f32x4*)(b + 8 * lane + 512 * j + 4);
#pragma unroll
        for (int i = 0; i < 4; ++i) { v[j][i] = v[j][i] * rstd * g0[i] + b0[i]; v[j][4 + i] = v[j][4 + i] * rstd * g1[i] + b1[i]; } }
}
__device__ __forceinline__ void store_row_fp8(const float (&v)[4][8], unsigned char* xrow, int lane) {
#pragma unroll
    for (int j = 0; j < 4; ++j) { u32x2 w; w.x = cvt4_fp8(v[j][0], v[j][1], v[j][2], v[j][3]); w.y = cvt4_fp8(v[j][4], v[j][5], v[j][6], v[j][7]); *(u32x2*)(xrow + 8 * lane + 512 * j) = w; }
}
__device__ __forceinline__ void store_row_bf16(const float (&v)[4][8], bf16* xrow, int lane) {
#pragma unroll
    for (int j = 0; j < 4; ++j) *(u32x4*)(xrow + 8 * lane + 512 * j) = pack8(v[j]);
}

struct Ptrs {
    const float* in[27]; float* out; unsigned char* ws;
};

struct CvItem { const float* src; unsigned char* dst; int ldn, pitch, f8; float scale; };
__device__ __forceinline__ CvItem cv_decode(const Ptrs& P, int it) {
    unsigned char* ws = P.ws; CvItem c;
    constexpr int I_LAYER = 8192 + 1024 + 1024 + 2048, I_EXP = 1408, N_A = 2 * I_LAYER, N_B = 3 * 32 * I_EXP;
    if (it < N_A) {
        const int l = it / I_LAYER; int r = it % I_LAYER;
        if (r < 8192) { const int kb = PROJ_F8 ? 2 * ((r >> 1) / 256) + (r & 1) : r / 256, nb = PROJ_F8 ? (r >> 1) % 256 : r % 256; c.src = P.in[3] + (size_t)l * D * DIN + (size_t)(64 * kb) * DIN + 32 * nb; c.ldn = DIN;
#if PROJ_F8
            c.dst = ws + WS_WIN + (size_t)l * DIN * D + (size_t)(32 * nb) * D + 64 * kb; c.pitch = D; c.f8 = 1; c.scale = 1.f;
#else
            c.dst = ws + WS_WIN + ((size_t)l * DIN * D + (size_t)(32 * nb) * D + 64 * kb) * 2; c.pitch = D * 2; c.f8 = 0; c.scale = 1.f;
#endif
            return c; }
        r -= 8192;
        if (r < 2048) { const int sg = r >> 10, q = r & 1023, kb = q / 64, nb = q % 64; c.src = P.in[sg ? 16 : 11] + (size_t)l * DR * D + (size_t)(64 * kb) * D + 32 * nb; c.ldn = D;
#if MIX_F8
            c.dst = ws + WS_WCAT + ((size_t)l * D * D + (size_t)(32 * nb) * D + sg * 1024 + 64 * kb); c.pitch = D; c.f8 = 1; c.scale = 1.f; return c; }
#else
            c.dst = ws + WS_WCAT + ((size_t)l * D * D + (size_t)(32 * nb) * D + sg * 1024 + 64 * kb) * 2; c.pitch = D * 2; c.f8 = 0; c.scale = 1.f; return c; }
#endif
        r -= 2048;
        { const int kb = r / 64, nb = r % 64; c.src = P.in[17] + (size_t)l * D * D + (size_t)(64 * kb) * D + 32 * nb; c.ldn = D;
#if MIX_F8
          c.dst = ws + WS_WOUT + ((size_t)l * D * D + (size_t)(32 * nb) * D + 64 * kb); c.pitch = D; c.f8 = 1; c.scale = 1.f; return c; }
#else
          c.dst = ws + WS_WOUT + ((size_t)l * D * D + (size_t)(32 * nb) * D + 64 * kb) * 2; c.pitch = D * 2; c.f8 = 0; c.scale = 1.f; return c; }
#endif
    } else if (it < N_A + N_B) {
        const int r = it - N_A, m = r / I_EXP, q = r % I_EXP, which = m / 32, le = m % 32;
        if (which < 2) { const int kb = 2 * ((q >> 1) / 44) + (q & 1), nb = (q >> 1) % 44, n0 = 32 * nb; const int drow = (n0 >> 7) * 256 + (n0 & 127) + which * 128;
            c.src = P.in[22 + which] + (size_t)le * D * DE + (size_t)(64 * kb) * DE + n0; c.ldn = DE; c.dst = ws + WS_W13 + (size_t)le * 2816 * D + (size_t)drow * D + 64 * kb; c.pitch = D; c.f8 = 1; c.scale = 1.f; return c; }
        { const int kb = 2 * ((q >> 1) / 64) + (q & 1), nb = (q >> 1) % 64; c.src = P.in[24] + (size_t)le * DE * D + (size_t)(64 * kb) * D + 32 * nb; c.ldn = D; c.dst = ws + WS_W2 + (size_t)le * D * DEP + (size_t)(32 * nb) * DEP + 64 * kb; c.pitch = DEP; c.f8 = 1; c.scale = 1.f; return c; }
    } else {
        const int r = it - N_A - N_B, m = r / 8, q = r % 8, which = m / 16, lh = m % 16, kb = q / 4, nb = q % 4;
        c.src = P.in[which ? 8 : 6] + (size_t)lh * HD * HD + (size_t)(64 * kb) * HD + 32 * nb; c.ldn = HD;
        c.dst = ws + (which ? WS_WX : WS_WA) + ((size_t)lh * HD * HD + (size_t)(32 * nb) * HD + 64 * kb) * 2; c.pitch = HD * 2; c.f8 = 0; c.scale = -1.44269504089f;
        return c;
    }
}
__device__ __forceinline__ void cv_load(const CvItem& c, f32x4 (&t)[8], int lane) {
    const int i = lane & 15, g = lane >> 4;
    const float* sp = c.src + (size_t)(16 * (i >> 2) + (i & 3)) * c.ldn + 8 * g;
#pragma unroll
    for (int b = 0; b < 4; ++b) { t[2 * b] = *(const f32x4*)(sp + (size_t)(4 * b) * c.ldn); t[2 * b + 1] = *(const f32x4*)(sp + (size_t)(4 * b) * c.ldn + 4); }
}
__device__ __forceinline__ void cv_store(const CvItem& c, const f32x4 (&t)[8], const bf16x8 (&bsel)[2][2], int lane) {
    const int i = lane & 15, g = lane >> 4;
    bf16x8 af[4];
#pragma unroll
    for (int b = 0; b < 4; ++b) { const f32x4 x = t[2 * b] * c.scale, y = t[2 * b + 1] * c.scale;
        u32x4 w; w.x = cvt_pk_bf16(x[0], x[1]); w.y = cvt_pk_bf16(x[2], x[3]); w.z = cvt_pk_bf16(y[0], y[1]); w.w = cvt_pk_bf16(y[2], y[3]); af[b] = __builtin_bit_cast(bf16x8, w); }
#pragma unroll
    for (int h = 0; h < 2; ++h) { f32x4 d[4];
#pragma unroll
        for (int b = 0; b < 4; ++b) d[b] = __builtin_amdgcn_mfma_f32_16x16x32_bf16(af[b], c.f8 ? bsel[h][1] : bsel[h][0], (f32x4){0.f, 0.f, 0.f, 0.f}, 0, 0, 0);
        unsigned char* rowp = c.dst + (size_t)(i + 16 * h) * c.pitch;
        if (c.f8) { u32x4 o; o.x = cvt4_fp8(d[0][0], d[0][1], d[0][2], d[0][3]); o.y = cvt4_fp8(d[1][0], d[1][1], d[1][2], d[1][3]); o.z = cvt4_fp8(d[2][0], d[2][1], d[2][2], d[2][3]); o.w = cvt4_fp8(d[3][0], d[3][1], d[3][2], d[3][3]);
            __builtin_nontemporal_store(o, (u32x4*)(rowp + 16 * g)); }
        else { u32x4 o0, o1; o0.x = cvt_pk_bf16(d[0][0], d[0][1]); o0.y = cvt_pk_bf16(d[0][2], d[0][3]); o0.z = cvt_pk_bf16(d[1][0], d[1][1]); o0.w = cvt_pk_bf16(d[1][2], d[1][3]);
            o1.x = cvt_pk_bf16(d[2][0], d[2][1]); o1.y = cvt_pk_bf16(d[2][2], d[2][3]); o1.z = cvt_pk_bf16(d[3][0], d[3][1]); o1.w = cvt_pk_bf16(d[3][2], d[3][3]);
            __builtin_nontemporal_store(o0, (u32x4*)(rowp + 32 * g)); __builtin_nontemporal_store(o1, (u32x4*)(rowp + 32 * g + 16)); } }
}
template <int MODE, int DP> __device__ __forceinline__ void cv_run(const Ptrs& P, int gw, int NGW, int lane) {
    constexpr int N_A = 2 * (8192 + 1024 + 1024 + 2048), N_B = 3 * 32 * 1408, N_C = 2 * 2 * 8 * 8;
    constexpr int NITEMS = MODE == 0 ? N_A + N_C : (MODE == 1 ? N_B : N_A + N_B + N_C);
    static_assert(N_A % 2 == 0 && N_B % 2 == 0 && N_C % 2 == 0, "items come in pairs");
    auto item = [&](int t) { return MODE == 0 ? (t < N_A ? t : t + N_B) : (MODE == 1 ? t + N_A : t); };
    bf16x8 bsel[2][2];
    { const int i = lane & 15, g = lane >> 4;
#pragma unroll
      for (int h = 0; h < 2; ++h) { unsigned w1[4], w64[4];
#pragma unroll
          for (int p = 0; p < 4; ++p) { const unsigned lo = (8 * g + 2 * p == i + 16 * h) ? 1u : 0u, hi = (8 * g + 2 * p + 1 == i + 16 * h) ? 1u : 0u; w1[p] = lo * 0x3F80u | hi * 0x3F800000u; w64[p] = lo * 0x4280u | hi * 0x42800000u; }
          bsel[h][0] = __builtin_bit_cast(bf16x8, (u32x4){w1[0], w1[1], w1[2], w1[3]}); bsel[h][1] = __builtin_bit_cast(bf16x8, (u32x4){w64[0], w64[1], w64[2], w64[3]}); } }
    auto seq = [&](int j) { return 2 * (gw + NGW * (j >> 1)) + (j & 1); };
    CvItem c[DP]; f32x4 t[DP][8];
#pragma unroll
    for (int s = 0; s < DP - 1; ++s) { const int i = seq(s); if (i < NITEMS) { c[s] = cv_decode(P, item(i)); cv_load(c[s], t[s], lane); } }
    for (int j = 0; seq(j) < NITEMS; j += DP) {
#pragma unroll
        for (int s = 0; s < DP; ++s) { constexpr int DM1 = DP - 1; const int nb = (s + DM1) % DP;
            const int in = seq(j + s + DM1); if (in < NITEMS) { c[nb] = cv_decode(P, item(in)); cv_load(c[nb], t[nb], lane); }
            if (seq(j + s) < NITEMS) cv_store(c[s], t[s], bsel, lane); }
    }
}
__device__ __forceinline__ void p_prologue(const Ptrs& P, LAS unsigned char* lds, int gw, int NGW, int wave, int lane, bool split) {
    unsigned char* ws = P.ws;
    if (split) cv_run<0, 3>(P, gw, NGW, lane); else cv_run<2, 3>(P, gw, NGW, lane);
    { const float* src = P.in[14]; bf16* dst = (bf16*)(ws + WS_WS);
      for (int i = gw * 64 + lane; i < 2 * 8 * 128 * 128 / 4; i += NGW * 64) { const f32x4 v = *(const f32x4*)(src + 4 * i); const int s0 = (4 * i) & 127, t = ((4 * i) >> 7) & 127;
          u32x2 w; w.x = cvt_pk_bf16(s0 <= t ? v.x : 0.f, s0 + 1 <= t ? v.y : 0.f); w.y = cvt_pk_bf16(s0 + 2 <= t ? v.z : 0.f, s0 + 3 <= t ? v.w : 0.f); *(u32x2*)(dst + 4 * i) = w; } }
    for (int i = gw * 64 + lane; i < (2 * NE * D) * 8; i += NGW * 64) { const int row = i >> 3, ch = i & 7; *(u32x4*)(ws + WS_W2 + (size_t)row * DEP + DE + 16 * ch) = (u32x4){0u, 0u, 0u, 0u}; }
    { const float* lam = P.in[10]; float* sp = (float*)(ws + WS_SP);
      for (int i = gw * 64 + lane; i < 2 * DR; i += NGW * 64) { sp[i] = -8.0f * 1.44269504089f * log1pf(expf(-lam[i])); sp[2 * DR + i] = -1.44269504089f * P.in[7][i]; sp[4 * DR + i] = -1.44269504089f * P.in[9][i]; } }
    { f32x4 ra[4], rc[4];
      if (gw < T) {
#pragma unroll
          for (int j = 0; j < 4; ++j) { ra[j] = *(const f32x4*)(P.in[0] + (size_t)gw * D + 8 * lane + 512 * j); rc[j] = *(const f32x4*)(P.in[0] + (size_t)gw * D + 8 * lane + 512 * j + 4); } }
      for (int m = gw; m < T; m += NGW) { float v[4][8];
#pragma unroll
          for (int j = 0; j < 4; ++j)
#pragma unroll
              for (int i = 0; i < 4; ++i) { v[j][i] = ra[j][i]; v[j][4 + i] = rc[j][i]; }
          const int mn = m + NGW;
          if (mn < T) {
#pragma unroll
              for (int j = 0; j < 4; ++j) { ra[j] = *(const f32x4*)(P.in[0] + (size_t)mn * D + 8 * lane + 512 * j); rc[j] = *(const f32x4*)(P.in[0] + (size_t)mn * D + 8 * lane + 512 * j + 4); } }
          ln_row32(v, P.in[1], P.in[2], lane); store_row_bf16(v, (bf16*)(ws + WS_XN) + (size_t)m * D, lane);
          if (PROJ_F8) store_row_fp8(v, ws + WS_X8 + (size_t)m * D, lane); } }
}

__device__ __forceinline__ float dpp_bc15(float v) { return __builtin_bit_cast(float, __builtin_amdgcn_update_dpp(0, __builtin_bit_cast(int, v), 0x15F, 0xF, 0xF, false)); }
template <int SH> __device__ __forceinline__ float dpp_shr(float v, float ident) {
    return __builtin_bit_cast(float, __builtin_amdgcn_update_dpp(__builtin_bit_cast(int, ident), __builtin_bit_cast(int, v), 0x110 + SH, 0xF, 0xF, false));
}
__device__ __forceinline__ void rnn_unit(const Ptrs& P, int l, int unit_, LAS unsigned char* lds, int tid_, int wid, bool dry = false) {
    int tid = tid_; asm volatile("" : "+v"(tid)); const int lane = tid & 63;
    int unit = unit_; asm volatile("" : "+s"(unit));
    const int c16 = unit >> 5, bh = unit & 31, b = bh >> 3, h = bh & 7;
    const int fr = lane & 15, g = lane >> 4;
    unsigned char* ws = P.ws;
    const int t0 = b * SEQ + 256 * c16;
    LAS unsigned char* WAl = lds; LAS unsigned char* WXl = lds + 32768; LAS unsigned char* XC = lds + 65536;
    LAS f32x2* AGGW = (LAS f32x2*)(lds + X_AGGW); LAS float* CWl = (LAS float*)(lds + X_CW);
    const rsrc_t rPm3 = mk_rsrc(ws + WS_PROJ - 3 * DIN * 2);
    const rsrc_t rP = mk_rsrc(ws + WS_PROJ); const rsrc_t rPst = mk_rsrc_n(ws + WS_PROJ, dry ? 0 : 0x7fffffff); const rsrc_t rHSst = mk_rsrc_n(ws + WS_HS8, dry ? 0 : 0x7fffffff);
    { const rsrc_t rA = mk_rsrc(ws + WS_WA), rX = mk_rsrc(ws + WS_WX); const unsigned so = uni((unsigned)(l * NH + h) * HD * HD * 2u);
#pragma unroll
      for (int k = 0; k < 4; ++k) { const int idx = tid + 512 * k, rho = idx >> 4, q = idx & 15, i = rho & 15, nt = rho >> 4, n = 32 * (i >> 2) + 4 * nt + (i & 3);
          const u32x4 a = bld128(rA, (unsigned)(n * HD + 8 * q) * 2u, so), x = bld128(rX, (unsigned)(n * HD + 8 * q) * 2u, so);
          *(LAS u32x4*)(WAl + rho * 256 + ((q ^ i) << 4)) = a; *(LAS u32x4*)(WXl + rho * 256 + ((q ^ i) << 4)) = x; } }
    if (tid < 96) { const rsrc_t rSP = mk_rsrc(ws + WS_SP); const int tb = tid >> 5, q4 = tid & 31;
        *(LAS f32x4*)(CWl + tb * 128 + 4 * q4) = bldf4(rSP, (unsigned)(q4 * 16), uni((unsigned)(l * DR + h * HD) * 4u) + (unsigned)tb * (2 * DR * 4)); }
    { const int q = tid & 15; const rsrc_t rCW = mk_rsrc(P.in[4]), rCB = mk_rsrc(P.in[5]);
      float w[4][8], bias[8];
#pragma unroll
      for (int k = 0; k < 4; ++k) { const unsigned so = uni((unsigned)((l * 4 + k) * DR + h * HD) * 4u); const f32x4 w0 = bldf4(rCW, q * 32u, so), w1 = bldf4(rCW, q * 32u + 16u, so); w[k][0] = w0.x; w[k][1] = w0.y; w[k][2] = w0.z; w[k][3] = w0.w; w[k][4] = w1.x; w[k][5] = w1.y; w[k][6] = w1.z; w[k][7] = w1.w; }
      { const unsigned so = uni((unsigned)(l * DR + h * HD) * 4u); const f32x4 b0 = bldf4(rCB, q * 32u, so), b1 = bldf4(rCB, q * 32u + 16u, so); bias[0] = b0.x; bias[1] = b0.y; bias[2] = b0.z; bias[3] = b0.w; bias[4] = b1.x; bias[5] = b1.y; bias[6] = b1.z; bias[7] = b1.w; }
      u32x4 xq[2][4];
#pragma unroll
      for (int k = 0; k < 4; ++k) xq[0][k] = bld128(rPm3, (unsigned)(((tid >> 4) + k) * DIN + 8 * q) * 2u, uni((unsigned)((t0 + 0) * DIN + h * HD) * 2u));
#pragma unroll
      for (int it = 0; it < 8; ++it) { const int r = (tid >> 4) + 32 * it; float a[8];
          if (it < 7) {
#pragma unroll
              for (int k = 0; k < 4; ++k) xq[(it + 1) & 1][k] = bld128(rPm3, (unsigned)(((tid >> 4) + k) * DIN + 8 * q) * 2u, uni((unsigned)((t0 + 32 * (it + 1)) * DIN + h * HD) * 2u)); }
#pragma unroll
          for (int j = 0; j < 8; ++j) a[j] = bias[j];
#pragma unroll
          for (int k = 0; k < 4; ++k) { const int s_ = 256 * c16 + r - 3 + k;
              u32x4 xv = xq[it & 1][k];
              if (s_ < 0) xv = (u32x4){0u, 0u, 0u, 0u};
              const unsigned xw[4] = {xv.x, xv.y, xv.z, xv.w};
#pragma unroll
              for (int j = 0; j < 4; ++j) { a[2 * j] += w[k][2 * j] * bf_lo(xw[j]); a[2 * j + 1] += w[k][2 * j + 1] * bf_hi(xw[j]); } }
          u32x4 o; o.x = cvt_pk_bf16(a[0], a[1]); o.y = cvt_pk_bf16(a[2], a[3]); o.z = cvt_pk_bf16(a[4], a[5]); o.w = cvt_pk_bf16(a[6], a[7]);
          *(LAS u32x4*)(XC + r * 256 + ((q ^ (r & 15)) << 4)) = o; } }
    __syncthreads();
    f32x4 PR[8][2], PI[8][2];
    { bf16x8 bx[2][4];
#pragma unroll
      for (int mt = 0; mt < 2; ++mt)
#pragma unroll
          for (int ks = 0; ks < 4; ++ks) bx[mt][ks] = *(const LAS bf16x8*)(XC + (32 * wid + 16 * mt + fr) * 256 + (((4 * ks + g) ^ fr) << 4));
#pragma unroll
      for (int nt = 0; nt < 8; ++nt) {
#pragma unroll
          for (int mt = 0; mt < 2; ++mt) { PR[nt][mt] = (f32x4){0.f, 0.f, 0.f, 0.f}; PI[nt][mt] = (f32x4){0.f, 0.f, 0.f, 0.f}; }
#pragma unroll
          for (int ks = 0; ks < 4; ++ks) { const bf16x8 aw = *(const LAS bf16x8*)(WAl + (16 * nt + fr) * 256 + (((4 * ks + g) ^ fr) << 4)), ax = *(const LAS bf16x8*)(WXl + (16 * nt + fr) * 256 + (((4 * ks + g) ^ fr) << 4));
#pragma unroll
              for (int mt = 0; mt < 2; ++mt) { PR[nt][mt] = __builtin_amdgcn_mfma_f32_16x16x32_bf16(aw, bx[mt][ks], PR[nt][mt], 0, 0, 0); PI[nt][mt] = __builtin_amdgcn_mfma_f32_16x16x32_bf16(ax, bx[mt][ks], PI[nt][mt], 0, 0, 0); } } } }
    {
#pragma unroll
      for (int nt = 0; nt < 8; ++nt) { const f32x4 sp4 = *(const LAS f32x4*)(CWl + 32 * g + 4 * nt), ba4 = *(const LAS f32x4*)(CWl + 128 + 32 * g + 4 * nt), bx4 = *(const LAS f32x4*)(CWl + 256 + 32 * g + 4 * nt);
#pragma unroll
          for (int mt = 0; mt < 2; ++mt) { const int row = 32 * wid + 16 * mt + fr; const u32x2 xw = *(const LAS u32x2*)(XC + row * 256 + (((4 * g + (nt >> 1)) ^ fr) << 4) + (nt & 1) * 8);
              const float xcv[4] = {bf_lo(xw.x), bf_hi(xw.x), bf_lo(xw.y), bf_hi(xw.y)};
#pragma unroll
              for (int j = 0; j < 4; ++j) { const float rg = __builtin_amdgcn_rcpf(1.0f + __builtin_amdgcn_exp2f(PR[nt][mt][j] + ba4[j])), ig = __builtin_amdgcn_rcpf(1.0f + __builtin_amdgcn_exp2f(PI[nt][mt][j] + bx4[j]));
                  const float a = __builtin_amdgcn_exp2f(rg * sp4[j]);
                  PR[nt][mt][j] = a; PI[nt][mt][j] = __builtin_amdgcn_sqrtf(fmaxf(fmaf(-a, a, 1.0f), 0.f)) * (ig * xcv[j]); } }
          if (nt & 1) asm volatile("" ::: "memory"); } }
    { float Pf[64], Hf[64];
#pragma unroll
      for (int nt = 0; nt < 8; ++nt)
#pragma unroll
          for (int mt = 0; mt < 2; ++mt)
#pragma unroll
              for (int j = 0; j < 4; ++j) { Pf[(nt * 2 + mt) * 4 + j] = PR[nt][mt][j]; Hf[(nt * 2 + mt) * 4 + j] = PI[nt][mt][j]; }
      __builtin_amdgcn_sched_barrier(0); asm volatile("s_nop 1" ::: "memory"); __builtin_amdgcn_sched_barrier(0);
#define SCAN_STEP(SH) do { \
      _Pragma("unroll") for (int e = 0; e < 64; ++e) asm volatile("v_fmac_f32_dpp %0, %0, %1 row_shr:" #SH " row_mask:0xf bank_mask:0xf" : "+v"(Hf[e]) : "v"(Pf[e])); \
      _Pragma("unroll") for (int e = 0; e < 64; ++e) asm volatile("v_mul_f32_dpp %0, %0, %0 row_shr:" #SH " row_mask:0xf bank_mask:0xf" : "+v"(Pf[e])); } while (0)
      SCAN_STEP(1); SCAN_STEP(2); SCAN_STEP(4); SCAN_STEP(8);
#undef SCAN_STEP
      __builtin_amdgcn_sched_barrier(0); asm volatile("s_nop 1" ::: "memory"); __builtin_amdgcn_sched_barrier(0);
#pragma unroll
      for (int nt = 0; nt < 8; ++nt)
#pragma unroll
          for (int mt = 0; mt < 2; ++mt)
#pragma unroll
              for (int j = 0; j < 4; ++j) { PR[nt][mt][j] = Pf[(nt * 2 + mt) * 4 + j]; PI[nt][mt][j] = Hf[(nt * 2 + mt) * 4 + j]; } }
#pragma unroll
    for (int nt = 0; nt < 8; ++nt)
#pragma unroll
        for (int j = 0; j < 4; ++j) { const float P0 = dpp_bc15(PR[nt][0][j]), H0 = dpp_bc15(PI[nt][0][j]); PI[nt][1][j] = fmaf(PR[nt][1][j], H0, PI[nt][1][j]); PR[nt][1][j] *= P0; }
    if (fr == 15) {
#pragma unroll
        for (int nt = 0; nt < 8; ++nt)
#pragma unroll
            for (int j = 0; j < 4; ++j) AGGW[wid * 128 + 32 * g + 4 * nt + j] = (f32x2){PR[nt][1][j], PI[nt][1][j]};
    }
    __syncthreads();
    {
        typedef GAS unsigned long long gu64; typedef GAS unsigned gu32;
        gu64* AGG64 = (gu64*)(ws + WS_AGG); gu32* CTL = (gu32*)(ws + WS_CTL);
        gu32* flg = CTL + CW_FLAG + (((l * NB + b) * 16) * NH + h) * 16;
        if (tid < 128) { float Pt = 1.f, Ht = 0.f;
#pragma unroll
            for (int w = 0; w < 8; ++w) { const f32x2 a = AGGW[w * 128 + tid]; Ht = fmaf(a.x, Ht, a.y); Pt *= a.x; }
            __hip_atomic_store(AGG64 + (size_t)(b * 16 + c16) * DR + h * HD + tid, ((unsigned long long)__float_as_uint(Ht) << 32) | __float_as_uint(Pt), RLX_AGENT);
            asm volatile("s_waitcnt vmcnt(0)" ::: "memory"); }
        __syncthreads();
        if (tid == 0) __hip_atomic_store(flg + c16 * NH * 16, 1u, RLX_AGENT);
        if (wid == 0 && c16 > 0) { unsigned spins = 0;
            for (;;) { const unsigned v = (lane < c16) ? __hip_atomic_load(flg + lane * NH * 16, RLX_AGENT) : 1u;
                if (__builtin_amdgcn_ballot_w64(v == 0u) == 0ull) break;
                __builtin_amdgcn_s_sleep(2);
                if ((++spins & 1023u) == 0u) { if (spins > (1u << 22) || __hip_atomic_load(CTL + CW_TMO, RLX_AGENT) != 0u) { if (lane == 0) __hip_atomic_store(CTL + CW_TMO, 1u, RLX_AGENT); break; } } } }
        __syncthreads();
        if (tid < 128) { float carry = 0.f; unsigned long long ag[15];
#pragma unroll
            for (int cc = 0; cc < 15; ++cc) ag[cc] = (cc < c16) ? __hip_atomic_load(AGG64 + (size_t)(b * 16 + cc) * DR + h * HD + tid, RLX_AGENT) : 0x000000003f800000ull;
#pragma unroll
            for (int cc = 0; cc < 15; ++cc) carry = fmaf(__uint_as_float((unsigned)ag[cc]), carry, __uint_as_float((unsigned)(ag[cc] >> 32)));
#pragma unroll
            for (int w = 0; w < 8; ++w) { CWl[w * 128 + tid] = carry; const f32x2 a = AGGW[w * 128 + tid]; carry = fmaf(a.x, carry, a.y); } }
        __syncthreads();
        { const unsigned lo = (unsigned)(fr * DIN + 32 * g) * 2u; u32x4 gt[2][4];
#pragma unroll
          for (int mt = 0; mt < 2; ++mt)
#pragma unroll
              for (int np = 0; np < 4; ++np) gt[mt][np] = bld128(rP, lo, uni((unsigned)((t0 + 32 * wid + 16 * mt) * DIN + 1024 + h * HD + 8 * np) * 2u));
#pragma unroll
          for (int mt = 0; mt < 2; ++mt)
#pragma unroll
              for (int np = 0; np < 4; ++np) { const f32x4 c0 = *(const LAS f32x4*)(CWl + wid * 128 + 32 * g + 8 * np), c1 = *(const LAS f32x4*)(CWl + wid * 128 + 32 * g + 8 * np + 4);
                  float gv[8], o[8]; unpack8(gt[mt][np], gv);
#pragma unroll
                  for (int j = 0; j < 4; ++j) { o[j] = fmaf(PR[2 * np][mt][j], c0[j], PI[2 * np][mt][j]) * gv[j]; o[4 + j] = fmaf(PR[2 * np + 1][mt][j], c1[j], PI[2 * np + 1][mt][j]) * gv[4 + j]; }
#if MIX_F8
                  { u32x2 w8; w8.x = cvt4_fp8(clamp448(o[0] * HS_SCALE), clamp448(o[1] * HS_SCALE), clamp448(o[2] * HS_SCALE), clamp448(o[3] * HS_SCALE)); w8.y = cvt4_fp8(clamp448(o[4] * HS_SCALE), clamp448(o[5] * HS_SCALE), clamp448(o[6] * HS_SCALE), clamp448(o[7] * HS_SCALE));
                    bst64(w8, rHSst, (unsigned)(fr * D + 32 * g), uni((unsigned)((t0 + 32 * wid + 16 * mt) * D + h * HD + 8 * np))); }
#else
                  bst128(pack8(o), rPst, lo, uni((unsigned)((t0 + 32 * wid + 16 * mt) * DIN + 1024 + h * HD + 8 * np) * 2u));
#endif
                  } }
        __syncthreads();
    }
}

__device__ __forceinline__ void sgu_half_unit(const Ptrs& P, int l, int hu_, LAS unsigned char* lds, int tid_, int wid, bool dry = false) {
    int tid = tid_; asm volatile("" : "+v"(tid)); const int lane = tid & 63;
    int hu = hu_; asm volatile("" : "+s"(hu));
    const int gh = hu & 1, bc = hu >> 1, b = bc >> 5, cc = bc & 31;
    const int fr = lane & 15, gq = lane >> 4;
    unsigned char* ws = P.ws;
    const rsrc_t rP = mk_rsrc(ws + WS_PROJ); const rsrc_t rPst = mk_rsrc_n(ws + WS_PROJ, dry ? 0 : 0x7fffffff); const rsrc_t rHSst = mk_rsrc_n(ws + WS_HS8, dry ? 0 : 0x7fffffff);
    const int t0 = b * SEQ + 128 * cc;
    LAS unsigned char* VT = lds;
    LAS f32x2* ST = (LAS f32x2*)(lds + X_AGGW);
#pragma unroll
    for (int q = 0; q < 4; ++q) { u32x4 ra[4], rb[4];
#pragma unroll
        for (int r = 0; r < 4; ++r) { const unsigned so = uni((unsigned)((t0 + 16 * wid + 4 * q + r) * DIN + 3072) * 2u); ra[r] = bld128(rP, lane * 16u, so); rb[r] = bld128(rP, lane * 16u, so + 1024u); }
#pragma unroll
        for (int r = 0; r < 4; ++r) { float xa[8], xb[8]; unpack8(ra[r], xa); unpack8(rb[r], xb); float sm = 0.f;
#pragma unroll
            for (int j = 0; j < 8; ++j) sm += xa[j] + xb[j];
            const float mean = wave_sum(sm) * (1.f / DR); float s2 = 0.f;
#pragma unroll
            for (int j = 0; j < 8; ++j) { const float d0 = xa[j] - mean, d1 = xb[j] - mean; s2 += d0 * d0 + d1 * d1; }
            const float rstd = 1.f / sqrtf(wave_sum(s2) * (1.f / DR) + LN_EPS);
            if (lane == 0) ST[16 * wid + 4 * q + r] = (f32x2){mean, rstd}; } }
    __syncthreads();
    const int s_ = tid >> 2, part = tid & 3; const rsrc_t rLG = mk_rsrc(P.in[12]), rLB = mk_rsrc(P.in[13]), rWS = mk_rsrc(ws + WS_WS);
    const f32x2 st = ST[s_]; const int kmax = wid >> 1;
    u32x4 xv[4];
#pragma unroll
    for (int j = 0; j < 4; ++j) xv[j] = bld128(rP, (unsigned)(s_ * DIN + 32 * part) * 2u, uni((unsigned)(t0 * DIN + 3072 + (4 * gh) * HD + 8 * j) * 2u));
    for (int gi = 0; gi < 4; ++gi) { const int grp = 4 * gh + gi; LAS unsigned char* VTb = VT + (gi & 1) * 32768;
#pragma unroll
      for (int j = 0; j < 4; ++j) { const unsigned xw[4] = {xv[j].x, xv[j].y, xv[j].z, xv[j].w};
          const unsigned sl = uni((unsigned)(l * DR + grp * HD + 8 * j) * 4u);
          const f32x4 g0 = bldf4(rLG, part * 128u, sl), g1 = bldf4(rLG, part * 128u + 16u, sl), b0 = bldf4(rLB, part * 128u, sl), b1 = bldf4(rLB, part * 128u + 16u, sl);
          const float gg[8] = {g0.x, g0.y, g0.z, g0.w, g1.x, g1.y, g1.z, g1.w}, bb[8] = {b0.x, b0.y, b0.z, b0.w, b1.x, b1.y, b1.z, b1.w};
#pragma unroll
          for (int e = 0; e < 8; ++e) { const float x = (e & 1) ? bf_hi(xw[e >> 1]) : bf_lo(xw[e >> 1]); const float v = (x - st.x) * st.y * gg[e] + bb[e];
              const int dch = 32 * part + 8 * j + e, i = ((dch >> 5) << 2) | (dch & 3), dt = (dch >> 2) & 7, rho = 16 * dt + i;
              *(LAS bf16*)(VTb + rho * 256 + (((s_ >> 3) ^ i) << 4) + (s_ & 7) * 2) = (bf16)(cvt_pk_bf16(v, 0.f) & 0xffffu); } }
      if (gi < 3) {
#pragma unroll
          for (int j = 0; j < 4; ++j) xv[j] = bld128(rP, (unsigned)(s_ * DIN + 32 * part) * 2u, uni((unsigned)(t0 * DIN + 3072 + (grp + 1) * HD + 8 * j) * 2u)); }
      bf16x8 wf[4];
#pragma unroll
      for (int ks = 0; ks < 4; ++ks) if (ks <= kmax) wf[ks] = __builtin_bit_cast(bf16x8, bld128(rWS, (unsigned)(fr * 128 + 8 * gq) * 2u, uni((unsigned)(((l * 8 + grp) * 128 + 16 * wid) * 128 + 32 * ks) * 2u)));
      const unsigned lo = (unsigned)(fr * DIN + 32 * gq) * 2u; u32x4 gu[4];
#pragma unroll
      for (int np = 0; np < 4; ++np) gu[np] = bld128(rP, lo, uni((unsigned)((t0 + 16 * wid) * DIN + 2048 + grp * HD + 8 * np) * 2u));
      const float bsv = P.in[15][(size_t)(l * 8 + grp) * 128 + 16 * wid + fr];
      __syncthreads();
      f32x4 acc[8];
#pragma unroll
      for (int dt = 0; dt < 8; ++dt) { acc[dt] = (f32x4){0.f, 0.f, 0.f, 0.f};
#pragma unroll
          for (int ks = 0; ks < 4; ++ks) if (ks <= kmax) { const bf16x8 av = *(const LAS bf16x8*)(VTb + (16 * dt + fr) * 256 + (((4 * ks + gq) ^ fr) << 4)); acc[dt] = __builtin_amdgcn_mfma_f32_16x16x32_bf16(av, wf[ks], acc[dt], 0, 0, 0); } }
#pragma unroll
      for (int np = 0; np < 4; ++np) { float gv[8], o[8]; unpack8(gu[np], gv);
#pragma unroll
          for (int j = 0; j < 4; ++j) { o[j] = (acc[2 * np][j] + bsv) * gv[j]; o[4 + j] = (acc[2 * np + 1][j] + bsv) * gv[4 + j]; }
#if MIX_F8
          { u32x2 w8; w8.x = cvt4_fp8(clamp448(o[0] * HS_SCALE), clamp448(o[1] * HS_SCALE), clamp448(o[2] * HS_SCALE), clamp448(o[3] * HS_SCALE)); w8.y = cvt4_fp8(clamp448(o[4] * HS_SCALE), clamp448(o[5] * HS_SCALE), clamp448(o[6] * HS_SCALE), clamp448(o[7] * HS_SCALE));
            bst64(w8, rHSst, (unsigned)(fr * D + 32 * gq), uni((unsigned)((t0 + 16 * wid) * D + 1024 + grp * HD + 8 * np))); }
#else
          bst128(pack8(o), rPst, lo, uni((unsigned)((t0 + 16 * wid) * DIN + 2048 + grp * HD + 8 * np) * 2u));
#endif
          }
    }
    __syncthreads();
}

__device__ __forceinline__ void p_ln1_router(const Ptrs& P, int l, LAS unsigned char* lds, int vblk, int G, int tid, int wid, int lane, bool dry = false) {
    unsigned char* ws = P.ws;
    for (int i = tid; i < 8192; i += 512) { const int k = i >> 2, q = i & 3, pos = (k & ~511) | ((k & 7) << 6) | ((k >> 3) & 63);
        *(LAS f32x4*)(lds + ((size_t)(q * 2048 + pos) << 4)) = *(const f32x4*)(P.in[20] + 4 * i); }
    LAS float* RES = (LAS float*)(lds + X_AGGW);
    LAS int* LCNT = (LAS int*)(lds + X_AGGW + 2048);
    LAS float* LOGS = (LAS float*)(lds + X_AGGW + 4096);
    __syncthreads();
    const float* g1 = P.in[18] + (size_t)l * D; const float* b1 = P.in[19] + (size_t)l * D; const float* rb = P.in[21];
    bf16* X = (bf16*)(ws + WS_XN);
    unsigned* gcnt = (unsigned*)(ws + WS_CTL) + CW_CNT + l * 64;
    for (int rb0 = vblk * 64; rb0 < T; rb0 += G * 64) {
        if (tid < 16) LCNT[tid] = 0;
        u32x4 raw[2][4];
#pragma unroll
        for (int rr = 0; rr < 2; ++rr)
#pragma unroll
            for (int j = 0; j < 4; ++j) raw[rr][j] = *(const u32x4*)(X + (size_t)(rb0 + wid * 8 + rr) * D + 8 * lane + 512 * j);
        for (int pr = 0; pr < 4; ++pr) {
            const int r0 = rb0 + wid * 8 + 2 * pr;
            float v0[4][8], v1[4][8];
#pragma unroll
            for (int j = 0; j < 4; ++j) { unpack8(raw[0][j], v0[j]); unpack8(raw[1][j], v1[j]); }
            if (pr < 3) {
#pragma unroll
                for (int rr = 0; rr < 2; ++rr)
#pragma unroll
                    for (int j = 0; j < 4; ++j) raw[rr][j] = *(const u32x4*)(X + (size_t)(r0 + 2 + rr) * D + 8 * lane + 512 * j); }
            ln_row32(v0, g1, b1, lane); ln_row32(v1, g1, b1, lane);
            if (!dry) { unsigned char* X8 = ws + WS_X8;
#pragma unroll
              for (int j = 0; j < 4; ++j) { u32x2 w0, w1; w0.x = cvt4_fp8(v0[j][0], v0[j][1], v0[j][2], v0[j][3]); w0.y = cvt4_fp8(v0[j][4], v0[j][5], v0[j][6], v0[j][7]); w1.x = cvt4_fp8(v1[j][0], v1[j][1], v1[j][2], v1[j][3]); w1.y = cvt4_fp8(v1[j][4], v1[j][5], v1[j][6], v1[j][7]);
                  *(u32x2*)(X8 + (size_t)r0 * D + 8 * lane + 512 * j) = w0; *(u32x2*)(X8 + (size_t)(r0 + 1) * D + 8 * lane + 512 * j) = w1; } }
            float a0[16], a1[16];
            { f32x2 p0[8], p1[8];
#pragma unroll
              for (int e = 0; e < 8; ++e) { p0[e] = (f32x2){0.f, 0.f}; p1[e] = (f32x2){0.f, 0.f}; }
#pragma unroll
              for (int j = 0; j < 4; ++j)
#pragma unroll
                  for (int i = 0; i < 8; ++i) { const int pos = 512 * j + 64 * i + lane; const f32x2 x0 = (f32x2){v0[j][i], v0[j][i]}, x1 = (f32x2){v1[j][i], v1[j][i]};
#pragma unroll
                      for (int q = 0; q < 4; ++q) { const f32x4 w = *(const LAS f32x4*)(lds + ((size_t)(q * 2048 + pos) << 4)); const f32x2 wl = (f32x2){w[0], w[1]}, wh = (f32x2){w[2], w[3]};
                          p0[2 * q] = __builtin_elementwise_fma(x0, wl, p0[2 * q]); p0[2 * q + 1] = __builtin_elementwise_fma(x0, wh, p0[2 * q + 1]);
                          p1[2 * q] = __builtin_elementwise_fma(x1, wl, p1[2 * q]); p1[2 * q + 1] = __builtin_elementwise_fma(x1, wh, p1[2 * q + 1]); } }
#pragma unroll
              for (int e = 0; e < 8; ++e) { a0[2 * e] = p0[e].x; a0[2 * e + 1] = p0[e].y; a1[2 * e] = p1[e].x; a1[2 * e + 1] = p1[e].y; } }
#pragma unroll
            for (int e = 0; e < 16; ++e) { a0[e] = wave_sum(a0[e]); a1[e] = wave_sum(a1[e]); }
            if (lane == 0) { const int rl = wid * 8 + 2 * pr;
#pragma unroll
                for (int q = 0; q < 4; ++q) { *(LAS f32x4*)(LOGS + rl * 16 + 4 * q) = (f32x4){a0[4 * q], a0[4 * q + 1], a0[4 * q + 2], a0[4 * q + 3]}; *(LAS f32x4*)(LOGS + (rl + 1) * 16 + 4 * q) = (f32x4){a1[4 * q], a1[4 * q + 1], a1[4 * q + 2], a1[4 * q + 3]}; } }
        }
        __syncthreads();
        if (tid < 64) { const int rl = tid;
                float sc[16]; float mx = -3.0e38f;
#pragma unroll
                for (int q = 0; q < 4; ++q) { const f32x4 lg = *(const LAS f32x4*)(LOGS + rl * 16 + 4 * q); sc[4 * q] = lg[0]; sc[4 * q + 1] = lg[1]; sc[4 * q + 2] = lg[2]; sc[4 * q + 3] = lg[3]; }
#pragma unroll
                for (int e = 0; e < 16; ++e) mx = fmaxf(mx, sc[e]);
                float sum = 0.f;
#pragma unroll
                for (int e = 0; e < 16; ++e) { sc[e] = expf(sc[e] - mx); sum += sc[e]; }
                const float inv = 1.0f / sum; float sel[16];
#pragma unroll
                for (int e = 0; e < 16; ++e) { sc[e] *= inv; sel[e] = sc[e] + rb[e]; }
                int best = 0; float bestv = -3.0e38f;
#pragma unroll
                for (int gI = 0; gI < 4; ++gI) { const float s0 = sel[4 * gI], s1 = sel[4 * gI + 1], s2 = sel[4 * gI + 2], s3 = sel[4 * gI + 3];
                    const float hi01 = fmaxf(s0, s1), lo01 = fminf(s0, s1), hi23 = fmaxf(s2, s3), lo23 = fminf(s2, s3);
                    const float top1 = fmaxf(hi01, hi23), top2 = fmaxf(fminf(hi01, hi23), hi01 >= hi23 ? lo01 : lo23);
                    const float gs = top1 + top2; if (gs > bestv) { bestv = gs; best = gI; } }
                float s4[4], p4[4];
#pragma unroll
                for (int c = 0; c < 4; ++c) { s4[c] = best == 0 ? sel[c] : (best == 1 ? sel[4 + c] : (best == 2 ? sel[8 + c] : sel[12 + c])); p4[c] = best == 0 ? sc[c] : (best == 1 ? sc[4 + c] : (best == 2 ? sc[8 + c] : sc[12 + c])); }
                int i0 = 0; float m0 = s4[0];
#pragma unroll
                for (int c = 1; c < 4; ++c) if (s4[c] > m0) { m0 = s4[c]; i0 = c; }
                int i1 = (i0 == 0) ? 1 : 0; float m1 = (i0 == 0) ? s4[1] : s4[0];
#pragma unroll
                for (int c = 1; c < 4; ++c) if (c != i0 && s4[c] > m1) { m1 = s4[c]; i1 = c; }
                const float p0 = i0 == 0 ? p4[0] : (i0 == 1 ? p4[1] : (i0 == 2 ? p4[2] : p4[3])), p1 = i1 == 0 ? p4[0] : (i1 == 1 ? p4[1] : (i1 == 2 ? p4[2] : p4[3]));
                const float ws_ = 1.0f / (p0 + p1);
                RES[rl * 4 + 0] = __int_as_float(4 * best + i0); RES[rl * 4 + 1] = __int_as_float(4 * best + i1); RES[rl * 4 + 2] = p0 * ws_; RES[rl * 4 + 3] = p1 * ws_;
        }
        __syncthreads();
        int e = 0, lp = 0; float gate = 0.f;
        if (tid < 128) { const int rl = tid >> 1, k = tid & 1; e = __float_as_int(RES[rl * 4 + k]); gate = RES[rl * 4 + 2 + k]; lp = atomicAdd((int*)&LCNT[e], 1); }
        __syncthreads();
        if (tid < 16) { const int c = LCNT[tid]; LCNT[16 + tid] = (c > 0 && !dry) ? (int)__hip_atomic_fetch_add(gcnt + tid, (unsigned)c, RLX_AGENT) : 0; }
        __syncthreads();
        if (tid < 128 && !dry) { const int rl = tid >> 1, k = tid & 1, tok = rb0 + rl, pos = LCNT[16 + e] + lp;
            ((int*)(ws + WS_LTOK))[e * CAP + pos] = tok; ((float*)(ws + WS_LGATE))[e * CAP + pos] = gate; ((int*)(ws + WS_TOKSLOT))[tok * 2 + k] = (e << 16) | pos; }
        __syncthreads();
    }
}

__device__ __forceinline__ int moe_table(const Ptrs& P, int l, LAS int* tab, int tid) {
    if (tid == 0) { const unsigned* gcnt = (const unsigned*)(P.ws + WS_CTL) + CW_CNT + l * 64; int n = 0, ps = 0;
        for (int e = 0; e < NE; ++e) { const int c = (int)__hip_atomic_load(gcnt + e, RLX_AGENT); const int nt = (c + 255) >> 8; tab[160 + e] = ps; tab[176 + e] = c;
            for (int r = 0; r < nt; ++r) tab[n++] = e | (r << 8);
            ps += nt * 256; }
        tab[192] = n; }
    __syncthreads();
    return tab[192];
}

__device__ __forceinline__ void unpack_fp8x8(const u32x2 w, float (&o)[8]) {
    const f32x2 a = __builtin_amdgcn_cvt_pk_f32_fp8((int)w.x, false), b = __builtin_amdgcn_cvt_pk_f32_fp8((int)w.x, true), c = __builtin_amdgcn_cvt_pk_f32_fp8((int)w.y, false), d = __builtin_amdgcn_cvt_pk_f32_fp8((int)w.y, true);
    o[0] = a.x; o[1] = a.y; o[2] = b.x; o[3] = b.y; o[4] = c.x; o[5] = c.y; o[6] = d.x; o[7] = d.y;
}
__device__ __forceinline__ void p_ln2(const Ptrs& P, int l, LAS unsigned char* lds, int tid, const LAS int* tab, int gw, int NGW, int lane, bool dry = false) {
    unsigned char* ws = P.ws; bf16* X = (bf16*)(ws + WS_XN); const unsigned char* YS = ws + WS_YS;
    { const float* src[4] = {P.in[18] + (size_t)l * D, P.in[19] + (size_t)l * D, P.in[25] + (size_t)l * D, P.in[26] + (size_t)l * D};
#pragma unroll
      for (int a = 0; a < 4; ++a) *(LAS f32x4*)(lds + a * 8192 + tid * 16) = *(const f32x4*)(src[a] + tid * 4); }
    const LAS float* g1 = (const LAS float*)lds; const LAS float* b1 = g1 + D; const LAS float* g2 = g1 + 2 * D; const LAS float* b2 = g1 + 3 * D;
    __syncthreads();
    const int* TS = (const int*)(ws + WS_TOKSLOT);
    u32x4 rx[4]; u32x2 ry0[4], ry1[4];
    { const int m = gw; if (m < T) { const int s0 = uni(TS[m * 2]), s1 = uni(TS[m * 2 + 1]); const size_t r0 = (size_t)(tab[160 + (s0 >> 16)] + (s0 & 0xffff)), r1 = (size_t)(tab[160 + (s1 >> 16)] + (s1 & 0xffff));
#pragma unroll
        for (int j = 0; j < 4; ++j) { rx[j] = *(const u32x4*)(X + (size_t)m * D + 8 * lane + 512 * j); ry0[j] = *(const u32x2*)(YS + r0 * D + 8 * lane + 512 * j); ry1[j] = *(const u32x2*)(YS + r1 * D + 8 * lane + 512 * j); } } }
    for (int m = gw; m < T; m += NGW) {
        float v[4][8]; u32x2 cy0[4], cy1[4];
#pragma unroll
        for (int j = 0; j < 4; ++j) { unpack8(rx[j], v[j]); cy0[j] = ry0[j]; cy1[j] = ry1[j]; }
        const int mn = m + NGW;
        if (mn < T) { const int s0 = uni(TS[mn * 2]), s1 = uni(TS[mn * 2 + 1]); const size_t r0 = (size_t)(tab[160 + (s0 >> 16)] + (s0 & 0xffff)), r1 = (size_t)(tab[160 + (s1 >> 16)] + (s1 & 0xffff));
#pragma unroll
            for (int j = 0; j < 4; ++j) { rx[j] = *(const u32x4*)(X + (size_t)mn * D + 8 * lane + 512 * j); ry0[j] = *(const u32x2*)(YS + r0 * D + 8 * lane + 512 * j); ry1[j] = *(const u32x2*)(YS + r1 * D + 8 * lane + 512 * j); } }
        ln_row32(v, g1, b1, lane);
#pragma unroll
        for (int j = 0; j < 4; ++j) { float y0[8], y1[8]; unpack_fp8x8(cy0[j], y0); unpack_fp8x8(cy1[j], y1);
#pragma unroll
            for (int i = 0; i < 8; ++i) v[j][i] = ALPHA * v[j][i] + (y0[i] + y1[i]) * (1.0f / YS_SCALE); }
        ln_row32(v, g2, b2, lane);
        if (dry) continue;
        if (l == DEPTH - 1) {
#pragma unroll
            for (int j = 0; j < 4; ++j) { *(f32x4*)(P.out + (size_t)m * D + 8 * lane + 512 * j) = (f32x4){v[j][0], v[j][1], v[j][2], v[j][3]}; *(f32x4*)(P.out + (size_t)m * D + 8 * lane + 512 * j + 4) = (f32x4){v[j][4], v[j][5], v[j][6], v[j][7]}; }
        } else { store_row_bf16(v, X + (size_t)m * D, lane); if (PROJ_F8) store_row_fp8(v, ws + WS_X8 + (size_t)m * D, lane); }
    }
}

__device__ __forceinline__ int TID() { int t = threadIdx.x; asm volatile("" : "+v"(t)); return t; }
constexpr int N_PHASES = 1 + 8 * DEPTH;
struct Args { Ptrs p; int ph_lo, ph_hi; };
__global__ void __launch_bounds__(NWAVES * 64, 2) mk_fwd(Args args) {
    extern __shared__ __attribute__((aligned(16))) unsigned char lds_raw[];
    LAS unsigned char* lds = (LAS unsigned char*)lds_raw;
    const int tid = threadIdx.x, lane = tid & 63, wid = __builtin_amdgcn_readfirstlane(tid >> 6);
    const int G = gridDim.x; const int bx = blockIdx.x; const int vcu = (G % 8 == 0) ? (bx % 8) * (G / 8) + bx / 8 : bx;
    const int gw = vcu * NWAVES + wid, NGW = G * NWAVES;
    const Ptrs& P = args.p;
    unsigned char* ws = P.ws;
    volatile LAS unsigned* MISC = (volatile LAS unsigned*)(lds + X_MISC);
    LAS int* TAB = (LAS int*)(lds + X_TAB);
    if (tid < 64) MISC[tid] = 0u;
    __syncthreads();
    XcdBarrier bar = xcd_barrier_post((unsigned*)(ws + WS_CTL) + CW_BAR, MISC + 8);
    const int lo = args.ph_lo, hi = args.ph_hi;
#ifndef PHMASK
#define PHMASK 0x3ff
#endif
#define PHON(b) (((PHMASK) >> (b)) & 1)
#ifndef REPEAT_MASK
#define REPEAT_MASK 0
#endif
#ifndef PROBE_FOLD
#define PROBE_FOLD 0
#endif
#ifndef XPROBE
#define XPROBE 0
#endif
#define REPS(b) for (int rep_ = 0; rep_ <= ((REPEAT_MASK >> (b)) & 1); ++rep_)
#define REPSYNC() do { if (rep_ == 0 && REPEAT_MASK) xcd_barrier(bar); } while (0)
#define IN(k) (lo <= (k) && (k) < hi)
#define SEAM(k) do { if (IN(k) && IN((k) + 1)) xcd_barrier(bar); } while (0)

    if (PHON(0) && IN(0)) { REPS(0) { p_prologue(P, lds, gw, NGW, wid, TID() & 63, gridDim.x == 256); if ((REPEAT_MASK >> 0) & 1) REPSYNC(); } } SEAM(0);

    for (int l = 0; l < DEPTH; ++l) {
        const int pb = 1 + 8 * l;
        if (PHON(1) && IN(pb + 0)) REPS(1) {
#if PROJ_F8
            const bool dryp = ((REPEAT_MASK >> 1) & 1) && rep_ == 0;

            const int slot = blockIdx.x >> 3; const bool sp0 = gridDim.x == 256 && l == 0, is_conv = slot & 1;
            if (sp0 && is_conv) { cv_run<1, CV_DEPTH>(P, ((bx & 7) * 16 + (slot >> 1)) * NWAVES + wid, 128 * NWAVES, TID() & 63); }
            {
            pg8::RegOrder S{(const char*)(ws + WS_X8), (const char*)(ws + WS_WIN) + (size_t)l * DIN * D, D, D, T / 256, DIN / 256, sp0 ? 128 : G, sp0 ? (is_conv ? 128 * (16 - PROJ_R2) : 0) + (slot >> 1) * 8 + (bx & 7) : bx, 1, PROJ_WGM, (dryp && PROBE_FOLD) ? 1 : 0, sp0 ? (is_conv ? PROJ_R2 : 16 - PROJ_R2) : (1 << 30)};
            pg8::EpiProj E{(bf16*)(ws + WS_PROJ), 1.0f / WIN_SCALE, dryp};
            pg8::gemm_phase<pg8::EpiProj, pg8::RegOrder, true>(lds, D, S, E, TID());
            }
#else
            pg8::RegOrder S{(const char*)(ws + WS_XN), (const char*)(ws + WS_WIN) + (size_t)l * DIN * D * 2, D, D, T / 256, DIN / 256, G, bx, 2};
            pg8::EpiProj E{(bf16*)(ws + WS_PROJ), 1.0f};
            pg8::gemm_phase(lds, D, S, E, TID());
#endif
            if ((REPEAT_MASK >> 1) & 1) REPSYNC();
        } SEAM(pb + 0);
        if (PHON(3) && IN(pb + 1)) REPS(3) { const bool dry = ((REPEAT_MASK >> 3) & 1) && rep_ == 0;
            if (!(dry && XPROBE == 2)) { if (vcu < 512 && vcu < G) rnn_unit(P, l, vcu, lds, tid, wid, dry); }
            if (!(dry && XPROBE == 1)) { for (int u = vcu; u < 256; u += G) sgu_half_unit(P, l, u, lds, tid, wid, dry); }
            if (!(dry && XPROBE == 2)) { for (int u = vcu + G; u < 512; u += G) rnn_unit(P, l, u, lds, tid, wid, dry); }
            if ((REPEAT_MASK >> 3) & 1) REPSYNC();
        } SEAM(pb + 1);
        if (PHON(4) && IN(pb + 2)) REPS(4) {
#if MIX_F8
            pg8::RegOrder S{(const char*)(ws + WS_HS8), (const char*)(ws + WS_WCAT) + (size_t)l * D * D, D, D, T / 256, D / 256, G, bx, 1, MIX_WGM};
            pg8::EpiYab E{(const bf16*)(ws + WS_PROJ), (bf16*)(ws + WS_MERGED)};
            pg8::gemm_phase<pg8::EpiYab, pg8::RegOrder, true>(lds, D, S, E, TID());
#else
            pg8::RegOrder S{(const char*)(ws + WS_PROJ) + 1024 * 2, (const char*)(ws + WS_WCAT) + (size_t)l * D * D * 2, DIN, D, T / 256, D / 256, G, bx, 2};
            pg8::EpiYab E{(const bf16*)(ws + WS_PROJ), (bf16*)(ws + WS_MERGED)};
            pg8::gemm_phase(lds, D, S, E, TID());
#endif
            if ((REPEAT_MASK >> 4) & 1) REPSYNC();
        } SEAM(pb + 2);
        if (PHON(5) && IN(pb + 3)) REPS(5) { const bool dry = ((REPEAT_MASK >> 5) & 1) && rep_ == 0;
#if MIX_F8
            pg8::RegOrder S{(const char*)(ws + WS_MERGED), (const char*)(ws + WS_WOUT) + (size_t)l * D * D, D, D, T / 256, D / 256, G, bx, 1, MIX_WGM};
            pg8::EpiWout E{(bf16*)(ws + WS_XN), dry};
            pg8::gemm_phase<pg8::EpiWout, pg8::RegOrder, true>(lds, D, S, E, TID());
#else
            pg8::RegOrder S{(const char*)(ws + WS_MERGED), (const char*)(ws + WS_WOUT) + (size_t)l * D * D * 2, D, D, T / 256, D / 256, G, bx, 2};
            pg8::EpiWout E{(bf16*)(ws + WS_XN), dry};
            pg8::gemm_phase(lds, D, S, E, TID());
#endif
            if ((REPEAT_MASK >> 5) & 1) REPSYNC();
        } SEAM(pb + 3);
        if (PHON(6) && IN(pb + 4)) REPS(6) { const bool dry = ((REPEAT_MASK >> 6) & 1) && rep_ == 0; const int t_ = TID(); p_ln1_router(P, l, lds, vcu, G, t_, wid, t_ & 63, dry); if ((REPEAT_MASK >> 6) & 1) REPSYNC(); } SEAM(pb + 4);
        if (PHON(7) && IN(pb + 5)) REPS(7) {
            const int nrt = moe_table(P, l, TAB, tid);
            pg8::MoeOrder1 S{(const char*)(ws + WS_X8), (const char*)(ws + WS_W13) + (size_t)l * NE * 2816 * D, (const int*)(ws + WS_LTOK), TAB, nrt, 11, G, bx, MOE_WGM};
            pg8::EpiMoe1 E{(unsigned char*)(ws + WS_HDN)};
            pg8::gemm_phase<pg8::EpiMoe1, pg8::MoeOrder1, true>(lds, D, S, E, TID());
            if ((REPEAT_MASK >> 7) & 1) REPSYNC();
        } SEAM(pb + 5);
        if (PHON(8) && IN(pb + 6)) REPS(8) {
            const int nrt = moe_table(P, l, TAB, tid);
            pg8::MoeOrder2 S{(const char*)(ws + WS_HDN), (const char*)(ws + WS_W2) + (size_t)l * NE * D * DEP, TAB, nrt, 8, G, bx, MOE_WGM};
            pg8::EpiMoe2 E{ws + WS_YS, (const float*)(ws + WS_LGATE), TAB};
            pg8::gemm_phase<pg8::EpiMoe2, pg8::MoeOrder2, true, true>(lds, DEP, S, E, TID());
            if ((REPEAT_MASK >> 8) & 1) REPSYNC();
        } SEAM(pb + 6);
        if (PHON(9) && IN(pb + 7)) REPS(9) { const bool dry = ((REPEAT_MASK >> 9) & 1) && rep_ == 0; (void)moe_table(P, l, TAB, tid); { const int t_ = TID(); p_ln2(P, l, lds, t_, TAB, gw, NGW, t_ & 63, dry); } if ((REPEAT_MASK >> 9) & 1) REPSYNC(); } SEAM(pb + 7);
    }
#undef IN
#undef SEAM
}

extern "C" void kernel_launch(void* const* d_in, const int* in_sizes, int n_in, void* d_out, int out_size, void* d_ws, size_t ws_size, hipStream_t stream) {
    static int grid = 0;
    if (grid == 0) {
        if (n_in != 27 || out_size != T * D || ws_size < WS_END) { fprintf(stderr, "kernel_launch: unexpected shapes (n_in %d, out %d, ws %zu)\n", n_in, out_size, ws_size); grid = -1; return; }
        int dev = 0, cus = 0, per_cu = 0;
        if (hipGetDevice(&dev) != hipSuccess || hipDeviceGetAttribute(&cus, hipDeviceAttributeMultiprocessorCount, dev) != hipSuccess) { grid = -1; return; }
        if (hipFuncSetAttribute((const void*)mk_fwd, hipFuncAttributeMaxDynamicSharedMemorySize, LDS_BYTES) != hipSuccess) { fprintf(stderr, "kernel_launch: hipFuncSetAttribute failed\n"); grid = -1; return; }
        if (hipOccupancyMaxActiveBlocksPerMultiprocessor(&per_cu, (const void*)mk_fwd, NWAVES * 64, LDS_BYTES) != hipSuccess || per_cu < 1) { fprintf(stderr, "kernel_launch: occupancy query says %d\n", per_cu); }
        (void)hipGetLastError();
        grid = cus;
    }
    if (grid < 0) return;
    (void)hipMemsetAsync((char*)d_ws + WS_CTL, 0, CTL_ZERO_BYTES, stream);
    Args a{};
    for (int i = 0; i < 27; ++i) a.p.in[i] = (const float*)d_in[i];
    a.p.out = (float*)d_out; a.p.ws = (unsigned char*)d_ws;
#if MK_N_LAUNCHES == 1
    a.ph_lo = 0; a.ph_hi = N_PHASES;
    hipLaunchKernelGGL(mk_fwd, dim3(grid), dim3(NWAVES * 64), LDS_BYTES, stream, a);
#else
#ifndef PH_STOP
#define PH_STOP N_PHASES
#endif
    for (int p = 0; p < PH_STOP; ++p) { a.ph_lo = p; a.ph_hi = p + 1; hipLaunchKernelGGL(mk_fwd, dim3(grid), dim3(NWAVES * 64), LDS_BYTES, stream, a); }
#endif
}
```

```cpp
#include <hip/hip_runtime.h>
#include <cstdio>
#include <cstdint>

#ifndef MK_N_LAUNCHES
#define MK_N_LAUNCHES 1
#define PROJ_R2 1
#define CV_DEPTH 3
#endif

#define LAS __attribute__((address_space(3)))
#define GAS __attribute__((address_space(1)))
typedef unsigned short bf16;
typedef short bf16x8 __attribute__((ext_vector_type(8)));
typedef float f32x4 __attribute__((ext_vector_type(4)));
typedef float f32x2 __attribute__((ext_vector_type(2)));
typedef unsigned u32x4 __attribute__((ext_vector_type(4)));
typedef unsigned u32x2 __attribute__((ext_vector_type(2)));
#define RLX_AGENT __ATOMIC_RELAXED, __HIP_MEMORY_SCOPE_AGENT
#define LDS_WAIT() asm volatile("s_waitcnt lgkmcnt(0)" ::: "memory")
#define VM_WAIT() asm volatile("s_waitcnt vmcnt(0)" ::: "memory")

constexpr int T = 16384, SEQ = 4096, NB = 4, D = 2048, DIN = 8192, DR = 1024, NH = 8, HD = 128, NE = 16, DE = 1408, DEPTH = 2;
constexpr int NGRP = 4, CAP = 16384;
constexpr float ALPHA = 1.41421356237309515f;
constexpr float LN_EPS = 1e-5f;
constexpr int NWAVES = 8;
constexpr int PROWS = 36864;
constexpr int DEP = 1536;
#ifndef PROJ_F8
#define PROJ_F8 1
#endif
#ifndef PROJ_WGM
#define PROJ_WGM 4
#endif
#ifndef MIX_WGM
#define MIX_WGM 4
#endif
#ifndef MOE_WGM
#define MOE_WGM 2
#endif
#ifndef MIX_F8
#define MIX_F8 1
#endif
constexpr float HS_SCALE = 8.f, MG_SCALE = 8.f, WMIX_SCALE = 64.f;
constexpr float WIN_SCALE = 64.f;
constexpr float W13_SCALE = 64.f, W2_SCALE = 64.f, HDN_SCALE = 8.f, YS_SCALE = 16.f;

constexpr size_t MiB = 1u << 20;
constexpr size_t WS_CTL = 0, CTL_ZERO_BYTES = 1 * MiB;
constexpr size_t WS_AGG = 1 * MiB;
constexpr size_t WS_ZSTAT = WS_AGG + 512 * 1024;
constexpr size_t WS_TOKSLOT = WS_ZSTAT + 128 * 1024;
constexpr size_t WS_SP = WS_TOKSLOT + 128 * 1024;
constexpr size_t WS_LTOK = 2 * MiB;
constexpr size_t WS_LGATE = 3 * MiB;
constexpr size_t WS_WA = 4 * MiB;
constexpr size_t WS_WX = WS_WA + 512 * 1024;
constexpr size_t WS_WS = 5 * MiB;
constexpr size_t WS_WIN = 8 * MiB;
constexpr size_t WS_WCAT = 72 * MiB;
constexpr size_t WS_WOUT = 88 * MiB;
constexpr size_t WS_W13 = 104 * MiB;
constexpr size_t WS_W2 = 456 * MiB;
constexpr size_t WS_XN = 632 * MiB;
constexpr size_t WS_MERGED = 696 * MiB;
constexpr size_t WS_PROJ = 760 * MiB;
constexpr size_t WS_HDN = 760 * MiB;
constexpr size_t WS_X8 = WS_MERGED;
constexpr size_t WS_YS = 864 * MiB;
constexpr size_t WS_HS8 = 1016 * MiB;
constexpr size_t WS_END = 1048 * MiB;
static_assert(WIN_SCALE == 64.f && W13_SCALE == 64.f && W2_SCALE == 64.f, "the fp8 weight scale lives in the prologue's selection matrix");
static_assert(WS_HDN + (size_t)PROWS * DEP <= WS_YS && WS_YS + (size_t)PROWS * D * 2 <= WS_HS8, "ws map");
constexpr int CW_BAR = 4096;
constexpr int CW_CNT = 16384;
constexpr int CW_FLAG = 32768;
constexpr int CW_TMO = 8;

constexpr int RING_BYTES = 131072;
constexpr int X_OFF = RING_BYTES;
constexpr int X_AGGW = X_OFF;
constexpr int X_CW = X_OFF + 8192;
constexpr int X_TAB = X_OFF + 12288;
constexpr int X_MISC = X_OFF + 13312;
constexpr int LDS_BYTES = X_OFF + 16384;

__device__ __forceinline__ unsigned cvt_pk_bf16(float lo, float hi) { unsigned r; asm volatile("v_cvt_pk_bf16_f32 %0, %1, %2" : "=v"(r) : "v"(lo), "v"(hi)); return r; }
__device__ __forceinline__ unsigned cvt4_fp8(float a, float b, float c, float d) { int w = __builtin_amdgcn_cvt_pk_fp8_f32(a, b, 0, false); w = __builtin_amdgcn_cvt_pk_fp8_f32(c, d, w, true); return (unsigned)w; }
__device__ __forceinline__ float clamp448(float x) { return __builtin_amdgcn_fmed3f(x, -448.f, 448.f); }
__device__ __forceinline__ unsigned pk_u8(float a, float b, float c, float d) { return __builtin_amdgcn_cvt_pk_u8_f32(d + 0.5f, 3, __builtin_amdgcn_cvt_pk_u8_f32(c + 0.5f, 2, __builtin_amdgcn_cvt_pk_u8_f32(b + 0.5f, 1, __builtin_amdgcn_cvt_pk_u8_f32(a + 0.5f, 0, 0u)))); }
__device__ __forceinline__ void unpack_u8x8(const u32x2 w, float (&o)[8]) { o[0] = (float)(w.x & 255u); o[1] = (float)((w.x >> 8) & 255u); o[2] = (float)((w.x >> 16) & 255u); o[3] = (float)(w.x >> 24); o[4] = (float)(w.y & 255u); o[5] = (float)((w.y >> 8) & 255u); o[6] = (float)((w.y >> 16) & 255u); o[7] = (float)(w.y >> 24); }
__device__ __forceinline__ float bf_lo(unsigned u) { return __uint_as_float(u << 16); }
__device__ __forceinline__ float bf_hi(unsigned u) { return __uint_as_float(u & 0xffff0000u); }
__device__ __forceinline__ void unpack8(const u32x4 w, float (&o)[8]) { o[0] = bf_lo(w.x); o[1] = bf_hi(w.x); o[2] = bf_lo(w.y); o[3] = bf_hi(w.y); o[4] = bf_lo(w.z); o[5] = bf_hi(w.z); o[6] = bf_lo(w.w); o[7] = bf_hi(w.w); }
__device__ __forceinline__ u32x4 pack8(const float (&v)[8]) { u32x4 w; w.x = cvt_pk_bf16(v[0], v[1]); w.y = cvt_pk_bf16(v[2], v[3]); w.z = cvt_pk_bf16(v[4], v[5]); w.w = cvt_pk_bf16(v[6], v[7]); return w; }
__device__ __forceinline__ float fast_sigmoid(float z) { return __builtin_amdgcn_rcpf(1.0f + __builtin_amdgcn_exp2f(-1.44269504089f * z)); }
__device__ __forceinline__ float gelu_tanh(float x) { return x * fast_sigmoid(1.5957691216f * (x + 0.044715f * x * x * x)); }
template <int CTRL, int RMASK> __device__ __forceinline__ float dpp_mov0(float v) {
    return __builtin_bit_cast(float, __builtin_amdgcn_update_dpp(0, __builtin_bit_cast(int, v), CTRL, RMASK, 0xF, false));
}
__device__ __forceinline__ float wave_sum(float v) {
    v += dpp_mov0<0xB1, 0xF>(v);
    v += dpp_mov0<0x4E, 0xF>(v);
    v += dpp_mov0<0x124, 0xF>(v);
    v += dpp_mov0<0x128, 0xF>(v);
    v += dpp_mov0<0x142, 0xA>(v);
    v += dpp_mov0<0x143, 0xC>(v);
    return __builtin_bit_cast(float, __builtin_amdgcn_readlane(__builtin_bit_cast(int, v), 63));
}

typedef __amdgpu_buffer_rsrc_t rsrc_t;
__device__ __forceinline__ rsrc_t mk_rsrc_n(const void* p, int n) { return __builtin_amdgcn_make_buffer_rsrc((void*)p, 0, n, 0x00020000); }
__device__ __forceinline__ rsrc_t mk_rsrc(const void* p) { return __builtin_amdgcn_make_buffer_rsrc((void*)p, 0, 0x7fffffff, 0x00020000); }
__device__ __forceinline__ u32x4 bld128(rsrc_t r, unsigned voff, unsigned soff) { return __builtin_bit_cast(u32x4, __builtin_amdgcn_raw_buffer_load_b128(r, (int)(voff + soff), 0, 0)); }
__device__ __forceinline__ void bst128(u32x4 v, rsrc_t r, unsigned voff, unsigned soff) { __builtin_amdgcn_raw_buffer_store_b128(v, r, (int)(voff + soff), 0, 0); }
__device__ __forceinline__ unsigned uni(unsigned x) { return (unsigned)__builtin_amdgcn_readfirstlane((int)x); }
__device__ __forceinline__ u32x2 bld64(rsrc_t r, unsigned voff, unsigned soff) { return __builtin_bit_cast(u32x2, __builtin_amdgcn_raw_buffer_load_b64(r, (int)(voff + soff), 0, 0)); }
__device__ __forceinline__ void bst64(u32x2 v, rsrc_t r, unsigned voff, unsigned soff) { __builtin_amdgcn_raw_buffer_store_b64(v, r, (int)(voff + soff), 0, 0); }
__device__ __forceinline__ f32x4 bldf4(rsrc_t r, unsigned voff, unsigned soff) { return __builtin_bit_cast(f32x4, bld128(r, voff, soff)); }

namespace pg8 {
constexpr int BM = 256, BK = 64, HALF = 128, HTB = HALF * BK * 2, NXCD = 8, WGM = 4;
__host__ __device__ __forceinline__ int lds_byte(int r, int c) { const int st = (r >> 4) * 2 + (c >> 5), rr = r & 15, cc = c & 31, ob = rr * 64 + cc * 2; return st * 1024 + (ob ^ (((ob >> 9) & 1) << 5)); }
__host__ __device__ __forceinline__ void stage_rc(int b, int& R, int& C) { const int st = b / 1024, sb = b % 1024, swz = sb ^ (((sb >> 9) & 1) << 5); R = (st >> 1) * 16 + swz / 64; C = (st & 1) * 32 + (swz % 64) / 2; }
__host__ __device__ __forceinline__ int perm32(int rho) { const int n = rho >> 4, i = rho & 15; return 8 * (i >> 2) + 4 * n + (i & 3); }

typedef int i32x8 __attribute__((ext_vector_type(8)));
__device__ __forceinline__ i32x8 cat8(bf16x8 a, bf16x8 b) { typedef int i32x4_ __attribute__((ext_vector_type(4))); const i32x4_ x = __builtin_bit_cast(i32x4_, a), y = __builtin_bit_cast(i32x4_, b); return __builtin_shufflevector(x, y, 0, 1, 2, 3, 4, 5, 6, 7); }
__device__ __forceinline__ void mfma_f8z(f32x4& acc, i32x8 a, i32x8 b, int sc) { asm volatile("v_mfma_scale_f32_16x16x128_f8f6f4 %0, %1, %2, 0, %3, %3 op_sel_hi:[0,0,0]" : "=&v"(acc) : "v"(a), "v"(b), "v"(sc)); }
__device__ __forceinline__ void mfma_f8(f32x4& acc, i32x8 a, i32x8 b, int sc) { asm volatile("v_mfma_scale_f32_16x16x128_f8f6f4 %0, %1, %2, %0, %3, %3 op_sel_hi:[0,0,0]" : "+v"(acc) : "v"(a), "v"(b), "v"(sc)); }
struct Unit { const char* A; const char* B; int row0, pn, aux; };

__device__ __forceinline__ bool tile_of(int i, int G, int c, int nM, int nN, int& pm, int& pn, int wgm = WGM) {
    const int nwg = nM * nN; const long L = (long)i * G + c; if (L >= nwg) return false;
    int wgid = (int)L; { const int q = nwg / NXCD, r = nwg % NXCD, xcd = wgid % NXCD, off = wgid / NXCD; wgid = (xcd < r ? xcd * (q + 1) : r * (q + 1) + (xcd - r) * q) + off; }
    const int nig = wgm * nN, gid = wgid / nig, fm = gid * wgm, gsz = (nM - fm) < wgm ? (nM - fm) : wgm;
    pm = fm + ((wgid % nig) % gsz); pn = (wgid % nig) / gsz; return true;
}
struct RegOrder {
    static constexpr bool GATHER = false, HALFROWS = false;
    const char* A; const char* Bt; int lda, K, nM, nN, G, c, esz; int wgm = WGM; int fold = 0; int imax = 1 << 30;
    __device__ __forceinline__ bool next(int i, Unit& u) const {
        int pm, pn; if (i >= imax || !tile_of(i, G, c, nM, nN, pm, pn, wgm)) return false;
        u.A = A + (size_t)(fold ? 0 : pm) * BM * lda * esz; u.B = Bt + (size_t)(fold ? 0 : pn) * BM * K * esz; u.row0 = pm * BM; u.pn = pn; u.aux = 0; return true;
    }
    __device__ __forceinline__ void voff(const Unit&, const int (&R)[2], const int (&C)[2], unsigned (&vo)[2][2]) const {
#pragma unroll
        for (int h = 0; h < 2; ++h)
#pragma unroll
            for (int i = 0; i < 2; ++i) vo[h][i] = (unsigned)((h * HALF + R[i]) * lda * esz) + (unsigned)C[i] * 2u;
    }
};
struct MoeOrder1 {
    static constexpr bool GATHER = true, HALFROWS = true;
    const char* XN; const char* Bt; const int* list; const LAS int* tab; int nM, nN, G, c, wgm;
    __device__ __forceinline__ bool next(int i, Unit& u) const {
        int pm, pn; if (!tile_of(i, G, c, nM, nN, pm, pn, wgm)) return false;
        const int tv = __builtin_amdgcn_readfirstlane(tab[pm]), e = tv & 255, rt = tv >> 8;
        const int vr = __builtin_amdgcn_readfirstlane(tab[176 + e]) - rt * BM;
        u.A = XN; u.B = Bt + (size_t)e * (2816u * 2048u) + (size_t)pn * BM * D; u.row0 = __builtin_amdgcn_readfirstlane(tab[160 + e]) + rt * BM; u.pn = pn; u.aux = tv | (vr <= HALF ? (1 << 30) : 0); return true;
    }
    __device__ __forceinline__ void voff(const Unit& u, const int (&R)[2], const int (&C)[2], unsigned (&vo)[2][2]) const {
        const int e = u.aux & 255, rt = (u.aux >> 8) & 0xffff, cnt = __builtin_amdgcn_readfirstlane(tab[176 + e]);
#pragma unroll
        for (int h = 0; h < 2; ++h)
#pragma unroll
            for (int i = 0; i < 2; ++i) { int p = rt * BM + h * HALF + R[i]; p = p < cnt ? p : cnt - 1; const int tok = list[e * CAP + p]; vo[h][i] = (unsigned)tok * (unsigned)D + (unsigned)C[i] * 2u; }
    }
};
struct MoeOrder2 {
    static constexpr bool GATHER = false, HALFROWS = true;
    const char* HDN; const char* Bt; const LAS int* tab; int nM, nN, G, c, wgm;
    __device__ __forceinline__ bool next(int i, Unit& u) const {
        int pm, pn, half = 0, split = 0;
        const int nwg = nM * nN, last = (nwg - 1) >> 8, lft = nwg - (last << 8);
        if (G == 256 && i == last && lft <= 128 && (lft & 7) == 0) { const int rank = c >> 3, x = c & 7; split = 1; half = rank & 1;
            if (8 * (rank >> 1) >= lft || !tile_of(0, 1, (last << 8) + 8 * (rank >> 1) + x, nM, nN, pm, pn, wgm)) return false;
        } else if (!tile_of(i, G, c, nM, nN, pm, pn, wgm)) return false;
        const int tv = __builtin_amdgcn_readfirstlane(tab[pm]), e = tv & 255, rt = tv >> 8;
        const int vr = __builtin_amdgcn_readfirstlane(tab[176 + e]) - rt * BM;
        if (half && vr <= HALF) return false;
        u.row0 = __builtin_amdgcn_readfirstlane(tab[160 + e]) + rt * BM + half * HALF; u.A = HDN + (size_t)u.row0 * DEP; u.B = Bt + (size_t)e * (2048u * (unsigned)DEP) + (size_t)pn * BM * DEP; u.pn = pn;
        u.aux = tv | ((split || vr <= HALF) ? (1 << 30) : 0); return true;
    }
    __device__ __forceinline__ void voff(const Unit&, const int (&R)[2], const int (&C)[2], unsigned (&vo)[2][2]) const {
#pragma unroll
        for (int h = 0; h < 2; ++h)
#pragma unroll
            for (int i = 0; i < 2; ++i) vo[h][i] = (unsigned)((h * HALF + R[i]) * DEP) + (unsigned)C[i] * 2u;
    }
};

typedef f32x4 Acc[2][2][4][2];


__device__ __forceinline__ f32x2 sigm2_pre(f32x2 z) { f32x2 e; e.x = __builtin_amdgcn_exp2f(z.x); e.y = __builtin_amdgcn_exp2f(z.y); const f32x2 d = e + 1.0f; f32x2 r; r.x = __builtin_amdgcn_rcpf(d.x); r.y = __builtin_amdgcn_rcpf(d.y); return r; }
struct EpiProj {
    static constexpr bool PERM = true; static constexpr int MIDT = 0;
    bf16* O; float isc; bool dry = false;
    __device__ __forceinline__ void mid(Acc&, const Unit&, int, int, int, int) const {}
    template <int ACT> __device__ __forceinline__ void run(const Acc& acc, const Unit& u, int wr, int wc, int fr, int fq) const {
        const rsrc_t rO = mk_rsrc_n(O, dry ? 0 : 0x7fffffff);
        const unsigned loff = (unsigned)(fr * DIN + 8 * fq) * 2u;
        const float zs = -1.44269504089f * isc, c1 = -1.44269504089f * 1.5957691216f, c2 = c1 * 0.044715f;
#pragma unroll
        for (int ai = 0; ai < 2; ++ai)
#pragma unroll
            for (int m = 0; m < 4; ++m) { const unsigned so = uni(((unsigned)(u.row0 + wr * 64 + ai * HALF + m * 16) * DIN + u.pn * BM + wc * 32) * 2u);
#pragma unroll
                for (int bj = 0; bj < 2; ++bj) { f32x2 y[4];
#pragma unroll
                    for (int p = 0; p < 4; ++p) { const f32x4 a4 = acc[ai][bj][m][p >> 1]; const f32x2 a = (p & 1) ? (f32x2){a4[2], a4[3]} : (f32x2){a4[0], a4[1]};
                        if (ACT == 0) y[p] = a * isc;
                        else if (ACT == 1) { const f32x2 x = a * isc; const f32x2 t = x * x; const f32x2 uu = t * c2 + c1; y[p] = x * sigm2_pre(x * uu); }
                        else y[p] = sigm2_pre(a * zs) * 255.0f; }
                    if (ACT == 2) {
                        u32x2 w; w.x = pk_u8(y[0].x, y[0].y, y[1].x, y[1].y); w.y = pk_u8(y[2].x, y[2].y, y[3].x, y[3].y);
                        bst64(w, rO, (unsigned)(fr * DIN * 2 + 8 * fq), uni((unsigned)(u.row0 + wr * 64 + ai * HALF + m * 16) * (DIN * 2) + 8192u + (unsigned)(u.pn * BM - 4096 + wc * 32 + bj * HALF)));
                    } else {
                    u32x4 w; w.x = cvt_pk_bf16(y[0].x, y[0].y); w.y = cvt_pk_bf16(y[1].x, y[1].y); w.z = cvt_pk_bf16(y[2].x, y[2].y); w.w = cvt_pk_bf16(y[3].x, y[3].y);
                    bst128(w, rO, loff, so + bj * HALF * 2); } } }
    }
    __device__ __forceinline__ void operator()(const Acc& acc, const Unit& u, int wr, int wc, int fr, int fq) const {
        if (u.pn < 4) run<0>(acc, u, wr, wc, fr, fq); else if (u.pn < 16) run<1>(acc, u, wr, wc, fr, fq); else run<2>(acc, u, wr, wc, fr, fq);
    }
};
struct EpiYab {
    static constexpr bool PERM = true; static constexpr int MIDT = MIX_F8 ? 8 : 16;
    const bf16* P; bf16* O;
    __device__ __forceinline__ void mid(Acc& acc, const Unit& u, int wr, int wc, int fr, int fq) const {
        const rsrc_t rP = mk_rsrc(P);
        const unsigned loff = (unsigned)(fr * DIN * 2 + 8 * fq);
#pragma unroll
        for (int ai = 0; ai < 2; ++ai) { u32x2 ga[4][2], gb[4][2];
#pragma unroll
            for (int m = 0; m < 4; ++m) { const unsigned so = uni((unsigned)(u.row0 + wr * 64 + ai * HALF + m * 16) * (DIN * 2) + 8192u + (unsigned)(u.pn * BM + wc * 32));
#pragma unroll
                for (int bj = 0; bj < 2; ++bj) { ga[m][bj] = bld64(rP, loff, so + bj * HALF); gb[m][bj] = bld64(rP, loff, so + 2048 + bj * HALF); } }
#pragma unroll
            for (int m = 0; m < 4; ++m)
#pragma unroll
                for (int bj = 0; bj < 2; ++bj) { float a[8], g[8]; unpack_u8x8(ga[m][bj], a); unpack_u8x8(gb[m][bj], g);
#pragma unroll
                    for (int j = 0; j < 4; ++j) { acc[ai][bj][m][0][j] *= a[j] * __builtin_amdgcn_rcpf(g[j] + 1e-18f); acc[ai][bj][m][1][j] *= a[4 + j] * __builtin_amdgcn_rcpf(g[4 + j] + 1e-18f); } }
            asm volatile("" ::: "memory"); }
    }
    __device__ __forceinline__ void operator()(const Acc& acc, const Unit& u, int wr, int wc, int fr, int fq) const {
        const rsrc_t rP = mk_rsrc(P), rO = mk_rsrc(O);
        const unsigned loffP = (unsigned)(fr * DIN * 2 + 8 * fq), loffO = (unsigned)(fr * D + 8 * fq) * 2u;
        u32x2 gb[2][4][2];
#pragma unroll
        for (int ai = 0; ai < 2; ++ai)
#pragma unroll
            for (int m = 0; m < 4; ++m) { const unsigned soP = uni((unsigned)(u.row0 + wr * 64 + ai * HALF + m * 16) * (DIN * 2) + 8192u + 2048u + (unsigned)(u.pn * BM + wc * 32));
#pragma unroll
                for (int bj = 0; bj < 2; ++bj) gb[ai][m][bj] = bld64(rP, loffP, soP + bj * HALF); }
        constexpr float I255 = 1.0f / 255.0f;
#pragma unroll
        for (int ai = 0; ai < 2; ++ai)
#pragma unroll
            for (int m = 0; m < 4; ++m) { const unsigned soO = uni((((unsigned)(u.row0 + wr * 64 + ai * HALF + m * 16)) * D + u.pn * BM + wc * 32) * 2u);
#pragma unroll
                for (int bj = 0; bj < 2; ++bj) { float g[8]; unpack_u8x8(gb[ai][m][bj], g);
#pragma unroll
                    for (int j = 0; j < 8; ++j) g[j] = (g[j] + 1e-18f) * I255;
#if MIX_F8
                    { constexpr float OS = MG_SCALE / (HS_SCALE * WMIX_SCALE);
                      u32x2 w8; w8.x = cvt4_fp8(clamp448(acc[ai][bj][m][0][0] * g[0] * OS), clamp448(acc[ai][bj][m][0][1] * g[1] * OS), clamp448(acc[ai][bj][m][0][2] * g[2] * OS), clamp448(acc[ai][bj][m][0][3] * g[3] * OS));
                      w8.y = cvt4_fp8(clamp448(acc[ai][bj][m][1][0] * g[4] * OS), clamp448(acc[ai][bj][m][1][1] * g[5] * OS), clamp448(acc[ai][bj][m][1][2] * g[6] * OS), clamp448(acc[ai][bj][m][1][3] * g[7] * OS));
                      bst64(w8, rO, (unsigned)(fr * D + 8 * fq), uni((unsigned)(u.row0 + wr * 64 + ai * HALF + m * 16) * D + u.pn * BM + wc * 32) + bj * HALF); }
#else
                    u32x4 w; w.x = cvt_pk_bf16(acc[ai][bj][m][0][0] * g[0], acc[ai][bj][m][0][1] * g[1]); w.y = cvt_pk_bf16(acc[ai][bj][m][0][2] * g[2], acc[ai][bj][m][0][3] * g[3]);
                    w.z = cvt_pk_bf16(acc[ai][bj][m][1][0] * g[4], acc[ai][bj][m][1][1] * g[5]); w.w = cvt_pk_bf16(acc[ai][bj][m][1][2] * g[6], acc[ai][bj][m][1][3] * g[7]);
                    bst128(w, rO, loffO, soO + bj * HALF * 2);
#endif
                    } }
    }
};
struct EpiWout {
    static constexpr bool PERM = true; static constexpr int MIDT = 0;
    bf16* X; bool dry;
    __device__ __forceinline__ void mid(Acc&, const Unit&, int, int, int, int) const {}
    __device__ __forceinline__ void operator()(const Acc& acc, const Unit& u, int wr, int wc, int fr, int fq) const {
        constexpr float AS = MIX_F8 ? 1.0f / (MG_SCALE * WMIX_SCALE) : 1.0f;
        const rsrc_t rX = mk_rsrc(X); const rsrc_t rXst = mk_rsrc_n(X, dry ? 0 : 0x7fffffff);
        const unsigned loff = (unsigned)(fr * D + 8 * fq) * 2u;
#pragma unroll
        for (int ai = 0; ai < 2; ++ai) { u32x4 xr[4][2];
#pragma unroll
            for (int m = 0; m < 4; ++m) { const unsigned so = uni(((unsigned)(u.row0 + wr * 64 + ai * HALF + m * 16) * D + u.pn * BM + wc * 32) * 2u);
#pragma unroll
                for (int bj = 0; bj < 2; ++bj) xr[m][bj] = bld128(rX, loff, so + bj * HALF * 2); }
#pragma unroll
            for (int m = 0; m < 4; ++m) { const unsigned so = uni(((unsigned)(u.row0 + wr * 64 + ai * HALF + m * 16) * D + u.pn * BM + wc * 32) * 2u);
#pragma unroll
                for (int bj = 0; bj < 2; ++bj) { float xv[8]; unpack8(xr[m][bj], xv);
                    u32x4 w; w.x = cvt_pk_bf16(ALPHA * xv[0] + acc[ai][bj][m][0][0] * AS, ALPHA * xv[1] + acc[ai][bj][m][0][1] * AS); w.y = cvt_pk_bf16(ALPHA * xv[2] + acc[ai][bj][m][0][2] * AS, ALPHA * xv[3] + acc[ai][bj][m][0][3] * AS);
                    w.z = cvt_pk_bf16(ALPHA * xv[4] + acc[ai][bj][m][1][0] * AS, ALPHA * xv[5] + acc[ai][bj][m][1][1] * AS); w.w = cvt_pk_bf16(ALPHA * xv[6] + acc[ai][bj][m][1][2] * AS, ALPHA * xv[7] + acc[ai][bj][m][1][3] * AS);
                    bst128(w, rXst, loff, so + bj * HALF * 2); } }
            asm volatile("" ::: "memory"); }
    }
};
struct EpiMoe1 {
    static constexpr bool PERM = true; static constexpr int MIDT = 0;
    unsigned char* O;
    __device__ __forceinline__ void mid(Acc&, const Unit&, int, int, int, int) const {}
    __device__ __forceinline__ void operator()(const Acc& acc, const Unit& u, int wr, int wc, int fr, int fq) const {
        const rsrc_t rO = mk_rsrc(O);
        const unsigned loff = (unsigned)(fr * DEP + 8 * fq);
        const int nai = (u.aux >> 30) & 1 ? 1 : 2;
        constexpr float IS = 1.0f / W13_SCALE, ZS = -1.44269504089f * IS, OS = HDN_SCALE * IS * IS;
#pragma unroll
        for (int ai = 0; ai < 2; ++ai) if (ai < nai)
#pragma unroll
            for (int m = 0; m < 4; ++m) { f32x2 y[4];
#pragma unroll
                for (int p = 0; p < 4; ++p) { const f32x4 a4 = acc[ai][0][m][p >> 1], b4 = acc[ai][1][m][p >> 1];
                    const f32x2 a = (p & 1) ? (f32x2){a4[2], a4[3]} : (f32x2){a4[0], a4[1]}, b = (p & 1) ? (f32x2){b4[2], b4[3]} : (f32x2){b4[0], b4[1]};
                    const f32x2 v = (a * sigm2_pre(a * ZS)) * (b * OS); y[p].x = clamp448(v.x); y[p].y = clamp448(v.y); }
                u32x2 w; w.x = cvt4_fp8(y[0].x, y[0].y, y[1].x, y[1].y); w.y = cvt4_fp8(y[2].x, y[2].y, y[3].x, y[3].y);
                const unsigned so = uni((unsigned)(u.row0 + wr * 64 + ai * HALF + m * 16) * DEP + u.pn * HALF + wc * 32);
                bst64(w, rO, loff, so);
                if (u.pn == 10) { unsigned z; asm volatile("v_mov_b32 %0, 0" : "=v"(z)); bst64((u32x2){z, z}, rO, loff, so + HALF); } }
    }
};
struct EpiMoe2 {
    static constexpr bool PERM = true; static constexpr int MIDT = 0;
    unsigned char* O; const float* gl; const LAS int* tab;
    __device__ __forceinline__ void mid(Acc&, const Unit&, int, int, int, int) const {}
    __device__ __forceinline__ void operator()(const Acc& acc, const Unit& u, int wr, int wc, int fr, int fq) const {
        const rsrc_t rO = mk_rsrc(O);
        const int e = u.aux & 255, cnt = __builtin_amdgcn_readfirstlane(tab[176 + e]), prow = u.row0 - __builtin_amdgcn_readfirstlane(tab[160 + e]); const int nai = (u.aux >> 30) & 1 ? 1 : 2;
        const unsigned loff = (unsigned)(fr * D + 8 * fq);
#pragma unroll
        for (int ai = 0; ai < 2; ++ai) if (ai < nai)
#pragma unroll
            for (int m = 0; m < 4; ++m) { const int rlu = wr * 64 + ai * HALF + m * 16; int p = prow + rlu + fr; p = p < cnt ? p : cnt - 1; const float g = gl[e * CAP + p] * (YS_SCALE / (HDN_SCALE * W2_SCALE));
                const unsigned so = uni((unsigned)(u.row0 + rlu) * D + u.pn * BM + wc * 32);
#pragma unroll
                for (int bj = 0; bj < 2; ++bj) { const f32x4 v0 = acc[ai][bj][m][0] * g, v1 = acc[ai][bj][m][1] * g;
                    u32x2 w; w.x = cvt4_fp8(clamp448(v0[0]), clamp448(v0[1]), clamp448(v0[2]), clamp448(v0[3])); w.y = cvt4_fp8(clamp448(v1[0]), clamp448(v1[1]), clamp448(v1[2]), clamp448(v1[3]));
                    bst64(w, rO, loff, so + bj * HALF); } }
    }
};

template <class Epi, class Sched, bool F8 = false, bool PADLAST = false>
__device__ __forceinline__ void gemm_phase(LAS unsigned char* lds, const int K, const Sched& S, const Epi& E, const int tid) {
    const int wid = __builtin_amdgcn_readfirstlane(tid >> 6), lane = tid & 63, wr = wid >> 2, wc = wid & 3, fr = lane & 15, fq = lane >> 4;
    const int nt = F8 ? K / 128 : K / BK; const int KB = F8 ? K : 2 * K;
    int R[2], C[2]; unsigned voffB[2];
#pragma unroll
    for (int i = 0; i < 2; ++i) { stage_rc(tid * 16 + i * 8192, R[i], C[i]); const int Rb = Epi::PERM ? ((R[i] & ~31) + perm32(R[i] & 31)) : R[i]; voffB[i] = (unsigned)(Rb * KB) + (unsigned)C[i] * 2u; }
    const size_t kstep = (size_t)(BK * 2);
    const size_t hstepB = (size_t)HALF * KB;
    const unsigned ldsw = (unsigned)wid * 1024u;
    const int aoff = lds_byte(wr * 64 + fr, fq * 8), boff = lds_byte(wc * 32 + fr, fq * 8);
#define PG8_SA(b, h) (((b) * 2 + (h)) * HTB)
#define PG8_SB(b, h) ((4 + (b) * 2 + (h)) * HTB)
#define PG8_STAGE(bufoff, gbase, voff) do { _Pragma("unroll") for (int _i = 0; _i < 2; ++_i) \
        __builtin_amdgcn_global_load_lds((const unsigned*)((const char*)(gbase) + (voff)[_i]), (LAS unsigned*)(lds + (bufoff) + ldsw + _i * 8192), 16, 0, 0); } while (0)
#define PG8_LDA(dst, b, h) do { _Pragma("unroll") for (int m = 0; m < 4; ++m) _Pragma("unroll") for (int k = 0; k < 2; ++k) dst[m][k] = *(const LAS bf16x8*)(lds + PG8_SA(b, h) + aoff + m * 2048 + k * 1024); } while (0)
#define PG8_LDB(dst, b, h) do { _Pragma("unroll") for (int n = 0; n < 2; ++n) _Pragma("unroll") for (int k = 0; k < 2; ++k) dst[n][k] = *(const LAS bf16x8*)(lds + PG8_SB(b, h) + boff + n * 2048 + k * 1024); } while (0)
#define PG8_MMA(ai, bj, At, Bt) do { __builtin_amdgcn_s_setprio(1); _Pragma("unroll") for (int m = 0; m < 4; ++m) _Pragma("unroll") for (int n = 0; n < 2; ++n) { \
        if constexpr (F8) mfma_f8(acc[ai][bj][m][n], cat8(Bt[n][0], Bt[n][1]), cat8(At[m][0], At[m][1]), sc1); \
        else { _Pragma("unroll") for (int k = 0; k < 2; ++k) acc[ai][bj][m][n] = __builtin_amdgcn_mfma_f32_16x16x32_bf16(Bt[n][k], At[m][k], acc[ai][bj][m][n], 0, 0, 0); } } __builtin_amdgcn_s_setprio(0); } while (0)
#define PG8_MMAZ(ai, bj, At, Bt) do { __builtin_amdgcn_s_setprio(1); _Pragma("unroll") for (int m = 0; m < 4; ++m) _Pragma("unroll") for (int n = 0; n < 2; ++n) { \
        if constexpr (F8) mfma_f8z(acc[ai][bj][m][n], cat8(Bt[n][0], Bt[n][1]), cat8(At[m][0], At[m][1]), sc1); \
        else { acc[ai][bj][m][n] = __builtin_amdgcn_mfma_f32_16x16x32_bf16(Bt[n][0], At[m][0], (f32x4){0.f, 0.f, 0.f, 0.f}, 0, 0, 0); acc[ai][bj][m][n] = __builtin_amdgcn_mfma_f32_16x16x32_bf16(Bt[n][1], At[m][1], acc[ai][bj][m][n], 0, 0, 0); } } __builtin_amdgcn_s_setprio(0); } while (0)
#define PG8_WAIT_V(n) asm volatile("s_waitcnt vmcnt(" #n ")" ::: "memory")
#define PG8_WAIT_L(n) asm volatile("s_waitcnt lgkmcnt(" #n ")" ::: "memory")
#define PG8_BAR __builtin_amdgcn_s_barrier()
#define PG8_SCHED __builtin_amdgcn_sched_barrier(0)
    Unit cur, nxt; int ui = 0;
    if (!S.next(0, cur)) return;
    int sc1 = 0x7f7f7f7f; asm volatile("" : "+v"(sc1));
    unsigned va[2][2], vn[2][2];
    S.voff(cur, R, C, va);
    Acc acc;
    bf16x8 At[4][2], B0[2][2], B1[2][2];
    const char* cA = cur.A; const char* cB = cur.B;
    PG8_STAGE(PG8_SB(0, 0), cB, voffB); PG8_STAGE(PG8_SB(0, 1), cB + hstepB, voffB); PG8_STAGE(PG8_SA(0, 0), cA, va[0]); PG8_STAGE(PG8_SA(0, 1), cA, va[1]);
    if (wr == 1) PG8_BAR;
    PG8_WAIT_V(2); PG8_BAR;
    PG8_STAGE(PG8_SB(1, 0), cB + kstep, voffB); PG8_STAGE(PG8_SA(1, 0), cA + kstep, va[0]); PG8_STAGE(PG8_SB(1, 1), cB + hstepB + kstep, voffB);
    PG8_WAIT_V(6); PG8_BAR;
    for (;;) {
        const bool has_next = S.next(ui + 1, nxt);
        if (Sched::GATHER && has_next) S.voff(nxt, R, C, vn);
        else {
#pragma unroll
            for (int h = 0; h < 2; ++h)
#pragma unroll
                for (int i = 0; i < 2; ++i) vn[h][i] = va[h][i]; }
        const char* nA = has_next ? nxt.A : cA; const char* nB = has_next ? nxt.B : cB;
        for (int t = 0; t < nt; t += 2) {
            const bool last = (t == nt - 2);
            const char* a1 = cA + (size_t)(t + 1) * kstep;
            const char* a2 = last ? nA : cA + (size_t)(t + 2) * kstep; const char* b2 = last ? nB : cB + (size_t)(t + 2) * kstep;
            const char* a3 = a2 + kstep; const char* b3 = b2 + kstep;
            unsigned v2[2][2];
#pragma unroll
            for (int h = 0; h < 2; ++h)
#pragma unroll
                for (int i = 0; i < 2; ++i) v2[h][i] = (Sched::GATHER && last) ? vn[h][i] : va[h][i];
            if constexpr (Epi::MIDT > 0) { if (t == Epi::MIDT) E.mid(acc, cur, wr, wc, fr, fq); }
            PG8_LDB(B0, 0, 0); PG8_LDB(B1, 0, 1); PG8_SCHED; PG8_LDA(At, 0, 0); PG8_STAGE(PG8_SA(1, 1), a1, va[1]);
            PG8_WAIT_V(8); PG8_WAIT_L(0); PG8_BAR; if (t == 0) { PG8_MMAZ(0, 0, At, B0); PG8_MMAZ(0, 1, At, B1); } else { PG8_MMA(0, 0, At, B0); PG8_MMA(0, 1, At, B1); } PG8_BAR; PG8_SCHED;
            const bool hrow = Sched::HALFROWS && ((cur.aux >> 30) & 1);
            if (!hrow) { PG8_LDA(At, 0, 1); } PG8_STAGE(PG8_SB(0, 0), b2, voffB); PG8_STAGE(PG8_SB(0, 1), b2 + hstepB, voffB); PG8_STAGE(PG8_SA(0, 0), a2, v2[0]);
            PG8_WAIT_V(8); PG8_WAIT_L(0); PG8_BAR; if (!hrow) { if (t == 0) { PG8_MMAZ(1, 0, At, B0); PG8_MMAZ(1, 1, At, B1); } else { PG8_MMA(1, 0, At, B0); PG8_MMA(1, 1, At, B1); } } PG8_BAR; PG8_SCHED;
            const bool skip = PADLAST && last;
            if (!skip) { PG8_LDB(B0, 1, 0); PG8_LDB(B1, 1, 1); PG8_SCHED; PG8_LDA(At, 1, 0); } PG8_STAGE(PG8_SA(0, 1), a2, v2[1]);
            PG8_WAIT_V(8); PG8_WAIT_L(0); PG8_BAR; if (!skip) { PG8_MMA(0, 0, At, B0); PG8_MMA(0, 1, At, B1); } PG8_BAR; PG8_SCHED;
            if (!skip && !hrow) { PG8_LDA(At, 1, 1); } PG8_STAGE(PG8_SB(1, 0), b3, voffB); PG8_STAGE(PG8_SB(1, 1), b3 + hstepB, voffB); PG8_STAGE(PG8_SA(1, 0), a3, v2[0]);
            PG8_WAIT_V(8); PG8_WAIT_L(0); PG8_BAR; if (!skip && !hrow) { PG8_MMA(1, 0, At, B0); PG8_MMA(1, 1, At, B1); } PG8_BAR; PG8_SCHED;
        }
        if (wr == 0) PG8_BAR;
        if constexpr (F8) asm volatile("s_nop 15\n\ts_nop 15" ::: "memory");
        E(acc, cur, wr, wc, fr, fq);
        if (!has_next) break;
        cur = nxt; cA = nA; cB = nB; ++ui;
#pragma unroll
        for (int h = 0; h < 2; ++h)
#pragma unroll
            for (int i = 0; i < 2; ++i) va[h][i] = vn[h][i];
        if (wr == 1) PG8_BAR;
    }
    PG8_WAIT_V(0);
    PG8_BAR;
#undef PG8_SA
#undef PG8_SB
#undef PG8_STAGE
#undef PG8_LDA
#undef PG8_LDB
#undef PG8_MMA
#undef PG8_WAIT_V
#undef PG8_WAIT_L
#undef PG8_BAR
#undef PG8_SCHED
}
}

#define XB_TMO      128
#define XB_XCNT(j)  (256  + 64 * (j))
#define XB_XSUB(j)  (1280 + 64 * (j))
#define XB_XGEN(j)  (2304 + 64 * (j))
#define XB_TOP      3328
#define XB_TOPGEN   3392
#define XCD_BAR_WORDS 3456
#define XB_SPIN_CAP (1u << 22)
__device__ __forceinline__ unsigned xb_ld(unsigned* p)              { return __hip_atomic_load(p, __ATOMIC_RELAXED, __HIP_MEMORY_SCOPE_AGENT); }
__device__ __forceinline__ unsigned xb_add(unsigned* p, unsigned v) { return __hip_atomic_fetch_add(p, v, __ATOMIC_RELAXED, __HIP_MEMORY_SCOPE_AGENT); }
__device__ __forceinline__ unsigned xb_xcc_id() { return (unsigned)__builtin_amdgcn_s_getreg((3 << 11) | 20) & 0xFu; }
#define XB_SPIN(cond, bar) do { unsigned _sp = 0; while (cond) { __builtin_amdgcn_s_sleep(1); \
    if ((++_sp & 255u) == 0u) { if (xb_ld(&(bar)[XB_TMO])) break; if (_sp > XB_SPIN_CAP) { atomicAdd(&(bar)[XB_TMO], 1u); break; } } } } while (0)
struct XcdBarrier { unsigned* bar; unsigned x; volatile LAS unsigned* st; };
__device__ __forceinline__ XcdBarrier xcd_barrier_post(unsigned* bar, volatile LAS unsigned* st) {
    XcdBarrier b; b.bar = bar; b.x = xb_xcc_id(); b.st = st;
    if (threadIdx.x == 0) (void)xb_add(&bar[XB_XCNT(b.x)], 1u);
    return b;
}
__device__ __forceinline__ void xcd_barrier_complete(unsigned* bar, unsigned x, unsigned& nloc, unsigned& nx) {
    const unsigned G = gridDim.x * gridDim.y * gridDim.z;
    unsigned sum, cnt, mine, sp = 0u;
    for (;;) {
        sum = 0u; cnt = 0u; mine = 0u;
#pragma unroll
        for (unsigned j = 0; j < 16; ++j) { const unsigned c = xb_ld(&bar[XB_XCNT(j)]); sum += c; cnt += (c > 0u) ? 1u : 0u; mine = (j == x) ? c : mine; }
        if (sum == G) break;
        __builtin_amdgcn_s_sleep(1);
        if ((++sp & 255u) == 0u) { if (xb_ld(&bar[XB_TMO])) break; if (sp > XB_SPIN_CAP) { atomicAdd(&bar[XB_TMO], 1u); break; } }
    }
    nloc = mine > 0u ? mine : 1u; nx = cnt > 0u ? cnt : 1u;
}
__device__ __forceinline__ void xcd_barrier(const XcdBarrier& b) {
    asm volatile("s_waitcnt vmcnt(0)" ::: "memory");
    __syncthreads();
    if (threadIdx.x == 0) {
        unsigned* bar = b.bar;
        __builtin_amdgcn_s_waitcnt(0);
        unsigned nloc = b.st[0], nx = b.st[1];
        if (nloc == 0u) { xcd_barrier_complete(bar, b.x, nloc, nx); b.st[0] = nloc; b.st[1] = nx; }
        const unsigned old = xb_add(&bar[XB_XSUB(b.x)], 1u);
        const unsigned gen = old / nloc;
        if (old + 1u == (gen + 1u) * nloc) {
            __builtin_amdgcn_fence(__ATOMIC_RELEASE, "agent");
            asm volatile("s_waitcnt vmcnt(0)" ::: "memory");
            const unsigned og = xb_add(&bar[XB_TOP], 1u);
            const unsigned tg = og / nx;
            if (og + 1u == (tg + 1u) * nx) xb_add(&bar[XB_TOPGEN], 1u);
            else XB_SPIN(xb_ld(&bar[XB_TOPGEN]) == tg, bar);
            xb_add(&bar[XB_XGEN(b.x)], 1u);
            asm volatile("buffer_inv sc1\n\ts_waitcnt vmcnt(0)" ::: "memory");
        } else {
            XB_SPIN(xb_ld(&bar[XB_XGEN(b.x)]) == gen, bar);
            __builtin_amdgcn_fence(__ATOMIC_ACQUIRE, "agent");
            asm volatile("s_waitcnt vmcnt(0)" ::: "memory");
        }
    }
    __syncthreads();
}

__device__ __forceinline__ void ln_row32(float (&v)[4][8], const float* g, const float* b, int lane) {
    float s = 0.f;
#pragma unroll
    for (int j = 0; j < 4; ++j)
#pragma unroll
        for (int i = 0; i < 8; ++i) s += v[j][i];
    const float mean = wave_sum(s) * (1.f / D); float s2 = 0.f;
#pragma unroll
    for (int j = 0; j < 4; ++j)
#pragma unroll
        for (int i = 0; i < 8; ++i) { v[j][i] -= mean; s2 += v[j][i] * v[j][i]; }
    const float rstd = 1.f / sqrtf(wave_sum(s2) * (1.f / D) + LN_EPS);
#pragma unroll
    for (int j = 0; j < 4; ++j) { const f32x4 g0 = *(const f32x4*)(g + 8 * lane + 512 * j), g1 = *(const f32x4*)(g + 8 * lane + 512 * j + 4), b0 = *(const f32x4*)(b + 8 * lane + 512 * j), b1 = *(const f32x4*)(b + 8 * lane + 512 * j + 4);
#pragma unroll
        for (int i = 0; i < 4; ++i) { v[j][i] = v[j][i] * rstd * g0[i] + b0[i]; v[j][4 + i] = v[j][4 + i] * rstd * g1[i] + b1[i]; } }
}
__device__ __forceinline__ void ln_row32(float (&v)[4][8], const LAS float* g, const LAS float* b, int lane) {
    float s = 0.f;
#pragma unroll
    for (int j = 0; j < 4; ++j)
#pragma unroll
        for (int i = 0; i < 8; ++i) s += v[j][i];
    const float mean = wave_sum(s) * (1.f / D); float s2 = 0.f;
#pragma unroll
    for (int j = 0; j < 4; ++j)
#pragma unroll
        for (int i = 0; i < 8; ++i) { v[j][i] -= mean; s2 += v[j][i] * v[j][i]; }
    const float rstd = 1.f / sqrtf(wave_sum(s2) * (1.f / D) + LN_EPS);
#pragma unroll
    for (int j = 0; j < 4; ++j) { const f32x4 g0 = *(const LAS f32x4*)(g + 8 * lane + 512 * j), g1 = *(const LAS f32x4*)(g + 8 * lane + 512 * j + 4), b0 = *(const LAS f32x4*)(b + 8 * lane + 512 * j), b1 = *(const LAS f32x4*)(b + 8 * lane + 512 * j + 4);
#pragma unroll
        for (int i = 0; i < 4; ++i) { v[j][i] = v[j][i] * rstd * g0[i] + b0[i]; v[j][4 + i] = v[j][4 + i] * rstd * g1[i] + b1[i]; } }
}
__device__ __forceinline__ void store_row_fp8(const float (&v)[4][8], unsigned char* xrow, int lane) {
#pragma unroll
    for (int j = 0; j < 4; ++j) { u32x2 w; w.x = cvt4_fp8(v[j][0], v[j][1], v[j][2], v[j][3]); w.y = cvt4_fp8(v[j][4], v[j][5], v[j][6], v[j][7]); *(u32x2*)(xrow + 8 * lane + 512 * j) = w; }
}
__device__ __forceinline__ void store_row_bf16(const float (&v)[4][8], bf16* xrow, int lane) {
#pragma unroll
    for (int j = 0; j < 4; ++j) *(u32x4*)(xrow + 8 * lane + 512 * j) = pack8(v[j]);
}

struct Ptrs {
    const float* in[27]; float* out; unsigned char* ws;
};

struct CvItem { const float* src; unsigned char* dst; int ldn, pitch, f8; float scale; };
__device__ __forceinline__ CvItem cv_decode(const Ptrs& P, int it) {
    unsigned char* ws = P.ws; CvItem c;
    constexpr int I_LAYER = 8192 + 1024 + 1024 + 2048, I_EXP = 1408, N_A = 2 * I_LAYER, N_B = 3 * 32 * I_EXP;
    if (it < N_A) {
        const int l = it / I_LAYER; int r = it % I_LAYER;
        if (r < 8192) { const int kb = PROJ_F8 ? 2 * ((r >> 1) / 256) + (r & 1) : r / 256, nb = PROJ_F8 ? (r >> 1) % 256 : r % 256; c.src = P.in[3] + (size_t)l * D * DIN + (size_t)(64 * kb) * DIN + 32 * nb; c.ldn = DIN;
#if PROJ_F8
            c.dst = ws + WS_WIN + (size_t)l * DIN * D + (size_t)(32 * nb) * D + 64 * kb; c.pitch = D; c.f8 = 1; c.scale = 1.f;
#else
            c.dst = ws + WS_WIN + ((size_t)l * DIN * D + (size_t)(32 * nb) * D + 64 * kb) * 2; c.pitch = D * 2; c.f8 = 0; c.scale = 1.f;
#endif
            return c; }
        r -= 8192;
        if (r < 2048) { const int sg = r >> 10, q = r & 1023, kb = q / 64, nb = q % 64; c.src = P.in[sg ? 16 : 11] + (size_t)l * DR * D + (size_t)(64 * kb) * D + 32 * nb; c.ldn = D;
#if MIX_F8
            c.dst = ws + WS_WCAT + ((size_t)l * D * D + (size_t)(32 * nb) * D + sg * 1024 + 64 * kb); c.pitch = D; c.f8 = 1; c.scale = 1.f; return c; }
#else
            c.dst = ws + WS_WCAT + ((size_t)l * D * D + (size_t)(32 * nb) * D + sg * 1024 + 64 * kb) * 2; c.pitch = D * 2; c.f8 = 0; c.scale = 1.f; return c; }
#endif
        r -= 2048;
        { const int kb = r / 64, nb = r % 64; c.src = P.in[17] + (size_t)l * D * D + (size_t)(64 * kb) * D + 32 * nb; c.ldn = D;
#if MIX_F8
          c.dst = ws + WS_WOUT + ((size_t)l * D * D + (size_t)(32 * nb) * D + 64 * kb); c.pitch = D; c.f8 = 1; c.scale = 1.f; return c; }
#else
          c.dst = ws + WS_WOUT + ((size_t)l * D * D + (size_t)(32 * nb) * D + 64 * kb) * 2; c.pitch = D * 2; c.f8 = 0; c.scale = 1.f; return c; }
#endif
    } else if (it < N_A + N_B) {
        const int r = it - N_A, m = r / I_EXP, q = r % I_EXP, which = m / 32, le = m % 32;
        if (which < 2) { const int kb = 2 * ((q >> 1) / 44) + (q & 1), nb = (q >> 1) % 44, n0 = 32 * nb; const int drow = (n0 >> 7) * 256 + (n0 & 127) + which * 128;
            c.src = P.in[22 + which] + (size_t)le * D * DE + (size_t)(64 * kb) * DE + n0; c.ldn = DE; c.dst = ws + WS_W13 + (size_t)le * 2816 * D + (size_t)drow * D + 64 * kb; c.pitch = D; c.f8 = 1; c.scale = 1.f; return c; }
        { const int kb = 2 * ((q >> 1) / 64) + (q & 1), nb = (q >> 1) % 64; c.src = P.in[24] + (size_t)le * DE * D + (size_t)(64 * kb) * D + 32 * nb; c.ldn = D; c.dst = ws + WS_W2 + (size_t)le * D * DEP + (size_t)(32 * nb) * DEP + 64 * kb; c.pitch = DEP; c.f8 = 1; c.scale = 1.f; return c; }
    } else {
        const int r = it - N_A - N_B, m = r / 8, q = r % 8, which = m / 16, lh = m % 16, kb = q / 4, nb = q % 4;
        c.src = P.in[which ? 8 : 6] + (size_t)lh * HD * HD + (size_t)(64 * kb) * HD + 32 * nb; c.ldn = HD;
        c.dst = ws + (which ? WS_WX : WS_WA) + ((size_t)lh * HD * HD + (size_t)(32 * nb) * HD + 64 * kb) * 2; c.pitch = HD * 2; c.f8 = 0; c.scale = -1.44269504089f;
        return c;
    }
}
__device__ __forceinline__ void cv_load(const CvItem& c, f32x4 (&t)[8], int lane) {
    const int i = lane & 15, g = lane >> 4;
    const float* sp = c.src + (size_t)(16 * (i >> 2) + (i & 3)) * c.ldn + 8 * g;
#pragma unroll
    for (int b = 0; b < 4; ++b) { t[2 * b] = *(const f32x4*)(sp + (size_t)(4 * b) * c.ldn); t[2 * b + 1] = *(const f32x4*)(sp + (size_t)(4 * b) * c.ldn + 4); }
}
__device__ __forceinline__ void cv_store(const CvItem& c, const f32x4 (&t)[8], const bf16x8 (&bsel)[2][2], int lane) {
    const int i = lane & 15, g = lane >> 4;
    bf16x8 af[4];
#pragma unroll
    for (int b = 0; b < 4; ++b) { const f32x4 x = t[2 * b] * c.scale, y = t[2 * b + 1] * c.scale;
        u32x4 w; w.x = cvt_pk_bf16(x[0], x[1]); w.y = cvt_pk_bf16(x[2], x[3]); w.z = cvt_pk_bf16(y[0], y[1]); w.w = cvt_pk_bf16(y[2], y[3]); af[b] = __builtin_bit_cast(bf16x8, w); }
#pragma unroll
    for (int h = 0; h < 2; ++h) { f32x4 d[4];
#pragma unroll
        for (int b = 0; b < 4; ++b) d[b] = __builtin_amdgcn_mfma_f32_16x16x32_bf16(af[b], c.f8 ? bsel[h][1] : bsel[h][0], (f32x4){0.f, 0.f, 0.f, 0.f}, 0, 0, 0);
        unsigned char* rowp = c.dst + (size_t)(i + 16 * h) * c.pitch;
        if (c.f8) { u32x4 o; o.x = cvt4_fp8(d[0][0], d[0][1], d[0][2], d[0][3]); o.y = cvt4_fp8(d[1][0], d[1][1], d[1][2], d[1][3]); o.z = cvt4_fp8(d[2][0], d[2][1], d[2][2], d[2][3]); o.w = cvt4_fp8(d[3][0], d[3][1], d[3][2], d[3][3]);
            __builtin_nontemporal_store(o, (u32x4*)(rowp + 16 * g)); }
        else { u32x4 o0, o1; o0.x = cvt_pk_bf16(d[0][0], d[0][1]); o0.y = cvt_pk_bf16(d[0][2], d[0][3]); o0.z = cvt_pk_bf16(d[1][0], d[1][1]); o0.w = cvt_pk_bf16(d[1][2], d[1][3]);
            o1.x = cvt_pk_bf16(d[2][0], d[2][1]); o1.y = cvt_pk_bf16(d[2][2], d[2][3]); o1.z = cvt_pk_bf16(d[3][0], d[3][1]); o1.w = cvt_pk_bf16(d[3][2], d[3][3]);
            __builtin_nontemporal_store(o0, (u32x4*)(rowp + 32 * g)); __builtin_nontemporal_store(o1, (u32x4*)(rowp + 32 * g + 16)); } }
}
template <int MODE, int DP> __device__ __forceinline__ void cv_run(const Ptrs& P, int gw, int NGW, int lane) {
    constexpr int N_A = 2 * (8192 + 1024 + 1024 + 2048), N_B = 3 * 32 * 1408, N_C = 2 * 2 * 8 * 8;
    constexpr int NITEMS = MODE == 0 ? N_A + N_C : (MODE == 1 ? N_B : N_A + N_B + N_C);
    static_assert(N_A % 2 == 0 && N_B % 2 == 0 && N_C % 2 == 0, "items come in pairs");
    auto item = [&](int t) { return MODE == 0 ? (t < N_A ? t : t + N_B) : (MODE == 1 ? t + N_A : t); };
    bf16x8 bsel[2][2];
    { const int i = lane & 15, g = lane >> 4;
#pragma unroll
      for (int h = 0; h < 2; ++h) { unsigned w1[4], w64[4];
#pragma unroll
          for (int p = 0; p < 4; ++p) { const unsigned lo = (8 * g + 2 * p == i + 16 * h) ? 1u : 0u, hi = (8 * g + 2 * p + 1 == i + 16 * h) ? 1u : 0u; w1[p] = lo * 0x3F80u | hi * 0x3F800000u; w64[p] = lo * 0x4280u | hi * 0x42800000u; }
          bsel[h][0] = __builtin_bit_cast(bf16x8, (u32x4){w1[0], w1[1], w1[2], w1[3]}); bsel[h][1] = __builtin_bit_cast(bf16x8, (u32x4){w64[0], w64[1], w64[2], w64[3]}); } }
    auto seq = [&](int j) { return 2 * (gw + NGW * (j >> 1)) + (j & 1); };
    CvItem c[DP]; f32x4 t[DP][8];
#pragma unroll
    for (int s = 0; s < DP - 1; ++s) { const int i = seq(s); if (i < NITEMS) { c[s] = cv_decode(P, item(i)); cv_load(c[s], t[s], lane); } }
    for (int j = 0; seq(j) < NITEMS; j += DP) {
#pragma unroll
        for (int s = 0; s < DP; ++s) { constexpr int DM1 = DP - 1; const int nb = (s + DM1) % DP;
            const int in = seq(j + s + DM1); if (in < NITEMS) { c[nb] = cv_decode(P, item(in)); cv_load(c[nb], t[nb], lane); }
            if (seq(j + s) < NITEMS) cv_store(c[s], t[s], bsel, lane); }
    }
}
__device__ __forceinline__ void p_prologue(const Ptrs& P, LAS unsigned char* lds, int gw, int NGW, int wave, int lane, bool split) {
    unsigned char* ws = P.ws;
    if (split) cv_run<0, 3>(P, gw, NGW, lane); else cv_run<2, 3>(P, gw, NGW, lane);
    { const float* src = P.in[14]; bf16* dst = (bf16*)(ws + WS_WS);
      for (int i = gw * 64 + lane; i < 2 * 8 * 128 * 128 / 4; i += NGW * 64) { const f32x4 v = *(const f32x4*)(src + 4 * i); const int s0 = (4 * i) & 127, t = ((4 * i) >> 7) & 127;
          u32x2 w; w.x = cvt_pk_bf16(s0 <= t ? v.x : 0.f, s0 + 1 <= t ? v.y : 0.f); w.y = cvt_pk_bf16(s0 + 2 <= t ? v.z : 0.f, s0 + 3 <= t ? v.w : 0.f); *(u32x2*)(dst + 4 * i) = w; } }
    for (int i = gw * 64 + lane; i < (2 * NE * D) * 8; i += NGW * 64) { const int row = i >> 3, ch = i & 7; *(u32x4*)(ws + WS_W2 + (size_t)row * DEP + DE + 16 * ch) = (u32x4){0u, 0u, 0u, 0u}; }
    { const float* lam = P.in[10]; float* sp = (float*)(ws + WS_SP);
      for (int i = gw * 64 + lane; i < 2 * DR; i += NGW * 64) { sp[i] = -8.0f * 1.44269504089f * log1pf(expf(-lam[i])); sp[2 * DR + i] = -1.44269504089f * P.in[7][i]; sp[4 * DR + i] = -1.44269504089f * P.in[9][i]; } }
    { f32x4 ra[4], rc[4];
      if (gw < T) {
#pragma unroll
          for (int j = 0; j < 4; ++j) { ra[j] = *(const f32x4*)(P.in[0] + (size_t)gw * D + 8 * lane + 512 * j); rc[j] = *(const f32x4*)(P.in[0] + (size_t)gw * D + 8 * lane + 512 * j + 4); } }
      for (int m = gw; m < T; m += NGW) { float v[4][8];
#pragma unroll
          for (int j = 0; j < 4; ++j)
#pragma unroll
              for (int i = 0; i < 4; ++i) { v[j][i] = ra[j][i]; v[j][4 + i] = rc[j][i]; }
          const int mn = m + NGW;
          if (mn < T) {
#pragma unroll
              for (int j = 0; j < 4; ++j) { ra[j] = *(const f32x4*)(P.in[0] + (size_t)mn * D + 8 * lane + 512 * j); rc[j] = *(const f32x4*)(P.in[0] + (size_t)mn * D + 8 * lane + 512 * j + 4); } }
          ln_row32(v, P.in[1], P.in[2], lane); store_row_bf16(v, (bf16*)(ws + WS_XN) + (size_t)m * D, lane);
          if (PROJ_F8) store_row_fp8(v, ws + WS_X8 + (size_t)m * D, lane); } }
}

__device__ __forceinline__ float dpp_bc15(float v) { return __builtin_bit_cast(float, __builtin_amdgcn_update_dpp(0, __builtin_bit_cast(int, v), 0x15F, 0xF, 0xF, false)); }
template <int SH> __device__ __forceinline__ float dpp_shr(float v, float ident) {
    return __builtin_bit_cast(float, __builtin_amdgcn_update_dpp(__builtin_bit_cast(int, ident), __builtin_bit_cast(int, v), 0x110 + SH, 0xF, 0xF, false));
}
__device__ __forceinline__ void rnn_unit(const Ptrs& P, int l, int unit_, LAS unsigned char* lds, int tid_, int wid, bool dry = false) {
    int tid = tid_; asm volatile("" : "+v"(tid)); const int lane = tid & 63;
    int unit = unit_; asm volatile("" : "+s"(unit));
    const int c16 = unit >> 5, bh = unit & 31, b = bh >> 3, h = bh & 7;
    const int fr = lane & 15, g = lane >> 4;
    unsigned char* ws = P.ws;
    const int t0 = b * SEQ + 256 * c16;
    LAS unsigned char* WAl = lds; LAS unsigned char* WXl = lds + 32768; LAS unsigned char* XC = lds + 65536;
    LAS f32x2* AGGW = (LAS f32x2*)(lds + X_AGGW); LAS float* CWl = (LAS float*)(lds + X_CW);
    const rsrc_t rPm3 = mk_rsrc(ws + WS_PROJ - 3 * DIN * 2);
    const rsrc_t rP = mk_rsrc(ws + WS_PROJ); const rsrc_t rPst = mk_rsrc_n(ws + WS_PROJ, dry ? 0 : 0x7fffffff); const rsrc_t rHSst = mk_rsrc_n(ws + WS_HS8, dry ? 0 : 0x7fffffff);
    { const rsrc_t rA = mk_rsrc(ws + WS_WA), rX = mk_rsrc(ws + WS_WX); const unsigned so = uni((unsigned)(l * NH + h) * HD * HD * 2u);
#pragma unroll
      for (int k = 0; k < 4; ++k) { const int idx = tid + 512 * k, rho = idx >> 4, q = idx & 15, i = rho & 15, nt = rho >> 4, n = 32 * (i >> 2) + 4 * nt + (i & 3);
          const u32x4 a = bld128(rA, (unsigned)(n * HD + 8 * q) * 2u, so), x = bld128(rX, (unsigned)(n * HD + 8 * q) * 2u, so);
          *(LAS u32x4*)(WAl + rho * 256 + ((q ^ i) << 4)) = a; *(LAS u32x4*)(WXl + rho * 256 + ((q ^ i) << 4)) = x; } }
    if (tid < 96) { const rsrc_t rSP = mk_rsrc(ws + WS_SP); const int tb = tid >> 5, q4 = tid & 31;
        *(LAS f32x4*)(CWl + tb * 128 + 4 * q4) = bldf4(rSP, (unsigned)(q4 * 16), uni((unsigned)(l * DR + h * HD) * 4u) + (unsigned)tb * (2 * DR * 4)); }
    { const int q = tid & 15; const rsrc_t rCW = mk_rsrc(P.in[4]), rCB = mk_rsrc(P.in[5]);
      float w[4][8], bias[8];
#pragma unroll
      for (int k = 0; k < 4; ++k) { const unsigned so = uni((unsigned)((l * 4 + k) * DR + h * HD) * 4u); const f32x4 w0 = bldf4(rCW, q * 32u, so), w1 = bldf4(rCW, q * 32u + 16u, so); w[k][0] = w0.x; w[k][1] = w0.y; w[k][2] = w0.z; w[k][3] = w0.w; w[k][4] = w1.x; w[k][5] = w1.y; w[k][6] = w1.z; w[k][7] = w1.w; }
      { const unsigned so = uni((unsigned)(l * DR + h * HD) * 4u); const f32x4 b0 = bldf4(rCB, q * 32u, so), b1 = bldf4(rCB, q * 32u + 16u, so); bias[0] = b0.x; bias[1] = b0.y; bias[2] = b0.z; bias[3] = b0.w; bias[4] = b1.x; bias[5] = b1.y; bias[6] = b1.z; bias[7] = b1.w; }
      u32x4 xq[2][4];
#pragma unroll
      for (int k = 0; k < 4; ++k) xq[0][k] = bld128(rPm3, (unsigned)(((tid >> 4) + k) * DIN + 8 * q) * 2u, uni((unsigned)((t0 + 0) * DIN + h * HD) * 2u));
#pragma unroll
      for (int it = 0; it < 8; ++it) { const int r = (tid >> 4) + 32 * it; float a[8];
          if (it < 7) {
#pragma unroll
              for (int k = 0; k < 4; ++k) xq[(it + 1) & 1][k] = bld128(rPm3, (unsigned)(((tid >> 4) + k) * DIN + 8 * q) * 2u, uni((unsigned)((t0 + 32 * (it + 1)) * DIN + h * HD) * 2u)); }
#pragma unroll
          for (int j = 0; j < 8; ++j) a[j] = bias[j];
#pragma unroll
          for (int k = 0; k < 4; ++k) { const int s_ = 256 * c16 + r - 3 + k;
              u32x4 xv = xq[it & 1][k];
              if (s_ < 0) xv = (u32x4){0u, 0u, 0u, 0u};
              const unsigned xw[4] = {xv.x, xv.y, xv.z, xv.w};
#pragma unroll
              for (int j = 0; j < 4; ++j) { a[2 * j] += w[k][2 * j] * bf_lo(xw[j]); a[2 * j + 1] += w[k][2 * j + 1] * bf_hi(xw[j]); } }
          u32x4 o; o.x = cvt_pk_bf16(a[0], a[1]); o.y = cvt_pk_bf16(a[2], a[3]); o.z = cvt_pk_bf16(a[4], a[5]); o.w = cvt_pk_bf16(a[6], a[7]);
          *(LAS u32x4*)(XC + r * 256 + ((q ^ (r & 15)) << 4)) = o; } }
    __syncthreads();
    f32x4 PR[8][2], PI[8][2];
    { bf16x8 bx[2][4];
#pragma unroll
      for (int mt = 0; mt < 2; ++mt)
#pragma unroll
          for (int ks = 0; ks < 4; ++ks) bx[mt][ks] = *(const LAS bf16x8*)(XC + (32 * wid + 16 * mt + fr) * 256 + (((4 * ks + g) ^ fr) << 4));
#pragma unroll
      for (int nt = 0; nt < 8; ++nt) {
#pragma unroll
          for (int mt = 0; mt < 2; ++mt) { PR[nt][mt] = (f32x4){0.f, 0.f, 0.f, 0.f}; PI[nt][mt] = (f32x4){0.f, 0.f, 0.f, 0.f}; }
#pragma unroll
          for (int ks = 0; ks < 4; ++ks) { const bf16x8 aw = *(const LAS bf16x8*)(WAl + (16 * nt + fr) * 256 + (((4 * ks + g) ^ fr) << 4)), ax = *(const LAS bf16x8*)(WXl + (16 * nt + fr) * 256 + (((4 * ks + g) ^ fr) << 4));
#pragma unroll
              for (int mt = 0; mt < 2; ++mt) { PR[nt][mt] = __builtin_amdgcn_mfma_f32_16x16x32_bf16(aw, bx[mt][ks], PR[nt][mt], 0, 0, 0); PI[nt][mt] = __builtin_amdgcn_mfma_f32_16x16x32_bf16(ax, bx[mt][ks], PI[nt][mt], 0, 0, 0); } } } }
    {
#pragma unroll
      for (int nt = 0; nt < 8; ++nt) { const f32x4 sp4 = *(const LAS f32x4*)(CWl + 32 * g + 4 * nt), ba4 = *(const LAS f32x4*)(CWl + 128 + 32 * g + 4 * nt), bx4 = *(const LAS f32x4*)(CWl + 256 + 32 * g + 4 * nt);
#pragma unroll
          for (int mt = 0; mt < 2; ++mt) { const int row = 32 * wid + 16 * mt + fr; const u32x2 xw = *(const LAS u32x2*)(XC + row * 256 + (((4 * g + (nt >> 1)) ^ fr) << 4) + (nt & 1) * 8);
              const float xcv[4] = {bf_lo(xw.x), bf_hi(xw.x), bf_lo(xw.y), bf_hi(xw.y)};
#pragma unroll
              for (int j = 0; j < 4; ++j) { const float rg = __builtin_amdgcn_rcpf(1.0f + __builtin_amdgcn_exp2f(PR[nt][mt][j] + ba4[j])), ig = __builtin_amdgcn_rcpf(1.0f + __builtin_amdgcn_exp2f(PI[nt][mt][j] + bx4[j]));
                  const float a = __builtin_amdgcn_exp2f(rg * sp4[j]);
                  PR[nt][mt][j] = a; PI[nt][mt][j] = __builtin_amdgcn_sqrtf(fmaxf(fmaf(-a, a, 1.0f), 0.f)) * (ig * xcv[j]); } }
          if (nt & 1) asm volatile("" ::: "memory"); } }
    { float Pf[64], Hf[64];
#pragma unroll
      for (int nt = 0; nt < 8; ++nt)
#pragma unroll
          for (int mt = 0; mt < 2; ++mt)
#pragma unroll
              for (int j = 0; j < 4; ++j) { Pf[(nt * 2 + mt) * 4 + j] = PR[nt][mt][j]; Hf[(nt * 2 + mt) * 4 + j] = PI[nt][mt][j]; }
      __builtin_amdgcn_sched_barrier(0); asm volatile("s_nop 1" ::: "memory"); __builtin_amdgcn_sched_barrier(0);
#define SCAN_STEP(SH) do { \
      _Pragma("unroll") for (int e = 0; e < 64; ++e) asm volatile("v_fmac_f32_dpp %0, %0, %1 row_shr:" #SH " row_mask:0xf bank_mask:0xf" : "+v"(Hf[e]) : "v"(Pf[e])); \
      _Pragma("unroll") for (int e = 0; e < 64; ++e) asm volatile("v_mul_f32_dpp %0, %0, %0 row_shr:" #SH " row_mask:0xf bank_mask:0xf" : "+v"(Pf[e])); } while (0)
      SCAN_STEP(1); SCAN_STEP(2); SCAN_STEP(4); SCAN_STEP(8);
#undef SCAN_STEP
      __builtin_amdgcn_sched_barrier(0); asm volatile("s_nop 1" ::: "memory"); __builtin_amdgcn_sched_barrier(0);
#pragma unroll
      for (int nt = 0; nt < 8; ++nt)
#pragma unroll
          for (int mt = 0; mt < 2; ++mt)
#pragma unroll
              for (int j = 0; j < 4; ++j) { PR[nt][mt][j] = Pf[(nt * 2 + mt) * 4 + j]; PI[nt][mt][j] = Hf[(nt * 2 + mt) * 4 + j]; } }
#pragma unroll
    for (int nt = 0; nt < 8; ++nt)
#pragma unroll
        for (int j = 0; j < 4; ++j) { const float P0 = dpp_bc15(PR[nt][0][j]), H0 = dpp_bc15(PI[nt][0][j]); PI[nt][1][j] = fmaf(PR[nt][1][j], H0, PI[nt][1][j]); PR[nt][1][j] *= P0; }
    if (fr == 15) {
#pragma unroll
        for (int nt = 0; nt < 8; ++nt)
#pragma unroll
            for (int j = 0; j < 4; ++j) AGGW[wid * 128 + 32 * g + 4 * nt + j] = (f32x2){PR[nt][1][j], PI[nt][1][j]};
    }
    __syncthreads();
    {
        typedef GAS unsigned long long gu64; typedef GAS unsigned gu32;
        gu64* AGG64 = (gu64*)(ws + WS_AGG); gu32* CTL = (gu32*)(ws + WS_CTL);
        gu32* flg = CTL + CW_FLAG + (((l * NB + b) * 16) * NH + h) * 16;
        if (tid < 128) { float Pt = 1.f, Ht = 0.f;
#pragma unroll
            for (int w = 0; w < 8; ++w) { const f32x2 a = AGGW[w * 128 + tid]; Ht = fmaf(a.x, Ht, a.y); Pt *= a.x; }
            __hip_atomic_store(AGG64 + (size_t)(b * 16 + c16) * DR + h * HD + tid, ((unsigned long long)__float_as_uint(Ht) << 32) | __float_as_uint(Pt), RLX_AGENT);
            asm volatile("s_waitcnt vmcnt(0)" ::: "memory"); }
        __syncthreads();
        if (tid == 0) __hip_atomic_store(flg + c16 * NH * 16, 1u, RLX_AGENT);
        if (wid == 0 && c16 > 0) { unsigned spins = 0;
            for (;;) { const unsigned v = (lane < c16) ? __hip_atomic_load(flg + lane * NH * 16, RLX_AGENT) : 1u;
                if (__builtin_amdgcn_ballot_w64(v == 0u) == 0ull) break;
                __builtin_amdgcn_s_sleep(2);
                if ((++spins & 1023u) == 0u) { if (spins > (1u << 22) || __hip_atomic_load(CTL + CW_TMO, RLX_AGENT) != 0u) { if (lane == 0) __hip_atomic_store(CTL + CW_TMO, 1u, RLX_AGENT); break; } } } }
        __syncthreads();
        if (tid < 128) { float carry = 0.f; unsigned long long ag[15];
#pragma unroll
            for (int cc = 0; cc < 15; ++cc) ag[cc] = (cc < c16) ? __hip_atomic_load(AGG64 + (size_t)(b * 16 + cc) * DR + h * HD + tid, RLX_AGENT) : 0x000000003f800000ull;
#pragma unroll
            for (int cc = 0; cc < 15; ++cc) carry = fmaf(__uint_as_float((unsigned)ag[cc]), carry, __uint_as_float((unsigned)(ag[cc] >> 32)));
#pragma unroll
            for (int w = 0; w < 8; ++w) { CWl[w * 128 + tid] = carry; const f32x2 a = AGGW[w * 128 + tid]; carry = fmaf(a.x, carry, a.y); } }
        __syncthreads();
        { const unsigned lo = (unsigned)(fr * DIN + 32 * g) * 2u; u32x4 gt[2][4];
#pragma unroll
          for (int mt = 0; mt < 2; ++mt)
#pragma unroll
              for (int np = 0; np < 4; ++np) gt[mt][np] = bld128(rP, lo, uni((unsigned)((t0 + 32 * wid + 16 * mt) * DIN + 1024 + h * HD + 8 * np) * 2u));
#pragma unroll
          for (int mt = 0; mt < 2; ++mt)
#pragma unroll
              for (int np = 0; np < 4; ++np) { const f32x4 c0 = *(const LAS f32x4*)(CWl + wid * 128 + 32 * g + 8 * np), c1 = *(const LAS f32x4*)(CWl + wid * 128 + 32 * g + 8 * np + 4);
                  float gv[8], o[8]; unpack8(gt[mt][np], gv);
#pragma unroll
                  for (int j = 0; j < 4; ++j) { o[j] = fmaf(PR[2 * np][mt][j], c0[j], PI[2 * np][mt][j]) * gv[j]; o[4 + j] = fmaf(PR[2 * np + 1][mt][j], c1[j], PI[2 * np + 1][mt][j]) * gv[4 + j]; }
#if MIX_F8
                  { u32x2 w8; w8.x = cvt4_fp8(clamp448(o[0] * HS_SCALE), clamp448(o[1] * HS_SCALE), clamp448(o[2] * HS_SCALE), clamp448(o[3] * HS_SCALE)); w8.y = cvt4_fp8(clamp448(o[4] * HS_SCALE), clamp448(o[5] * HS_SCALE), clamp448(o[6] * HS_SCALE), clamp448(o[7] * HS_SCALE));
                    bst64(w8, rHSst, (unsigned)(fr * D + 32 * g), uni((unsigned)((t0 + 32 * wid + 16 * mt) * D + h * HD + 8 * np))); }
#else
                  bst128(pack8(o), rPst, lo, uni((unsigned)((t0 + 32 * wid + 16 * mt) * DIN + 1024 + h * HD + 8 * np) * 2u));
#endif
                  } }
        __syncthreads();
    }
}

__device__ __forceinline__ void sgu_half_unit(const Ptrs& P, int l, int hu_, LAS unsigned char* lds, int tid_, int wid, bool dry = false) {
    int tid = tid_; asm volatile("" : "+v"(tid)); const int lane = tid & 63;
    int hu = hu_; asm volatile("" : "+s"(hu));
    const int gh = hu & 1, bc = hu >> 1, b = bc >> 5, cc = bc & 31;
    const int fr = lane & 15, gq = lane >> 4;
    unsigned char* ws = P.ws;
    const rsrc_t rP = mk_rsrc(ws + WS_PROJ); const rsrc_t rPst = mk_rsrc_n(ws + WS_PROJ, dry ? 0 : 0x7fffffff); const rsrc_t rHSst = mk_rsrc_n(ws + WS_HS8, dry ? 0 : 0x7fffffff);
    const int t0 = b * SEQ + 128 * cc;
    LAS unsigned char* VT = lds;
    LAS f32x2* ST = (LAS f32x2*)(lds + X_AGGW);
#pragma unroll
    for (int q = 0; q < 4; ++q) { u32x4 ra[4], rb[4];
#pragma unroll
        for (int r = 0; r < 4; ++r) { const unsigned so = uni((unsigned)((t0 + 16 * wid + 4 * q + r) * DIN + 3072) * 2u); ra[r] = bld128(rP, lane * 16u, so); rb[r] = bld128(rP, lane * 16u, so + 1024u); }
#pragma unroll
        for (int r = 0; r < 4; ++r) { float xa[8], xb[8]; unpack8(ra[r], xa); unpack8(rb[r], xb); float sm = 0.f;
#pragma unroll
            for (int j = 0; j < 8; ++j) sm += xa[j] + xb[j];
            const float mean = wave_sum(sm) * (1.f / DR); float s2 = 0.f;
#pragma unroll
            for (int j = 0; j < 8; ++j) { const float d0 = xa[j] - mean, d1 = xb[j] - mean; s2 += d0 * d0 + d1 * d1; }
            const float rstd = 1.f / sqrtf(wave_sum(s2) * (1.f / DR) + LN_EPS);
            if (lane == 0) ST[16 * wid + 4 * q + r] = (f32x2){mean, rstd}; } }
    __syncthreads();
    const int s_ = tid >> 2, part = tid & 3; const rsrc_t rLG = mk_rsrc(P.in[12]), rLB = mk_rsrc(P.in[13]), rWS = mk_rsrc(ws + WS_WS);
    const f32x2 st = ST[s_]; const int kmax = wid >> 1;
    u32x4 xv[4];
#pragma unroll
    for (int j = 0; j < 4; ++j) xv[j] = bld128(rP, (unsigned)(s_ * DIN + 32 * part) * 2u, uni((unsigned)(t0 * DIN + 3072 + (4 * gh) * HD + 8 * j) * 2u));
    for (int gi = 0; gi < 4; ++gi) { const int grp = 4 * gh + gi; LAS unsigned char* VTb = VT + (gi & 1) * 32768;
#pragma unroll
      for (int j = 0; j < 4; ++j) { const unsigned xw[4] = {xv[j].x, xv[j].y, xv[j].z, xv[j].w};
          const unsigned sl = uni((unsigned)(l * DR + grp * HD + 8 * j) * 4u);
          const f32x4 g0 = bldf4(rLG, part * 128u, sl), g1 = bldf4(rLG, part * 128u + 16u, sl), b0 = bldf4(rLB, part * 128u, sl), b1 = bldf4(rLB, part * 128u + 16u, sl);
          const float gg[8] = {g0.x, g0.y, g0.z, g0.w, g1.x, g1.y, g1.z, g1.w}, bb[8] = {b0.x, b0.y, b0.z, b0.w, b1.x, b1.y, b1.z, b1.w};
#pragma unroll
          for (int e = 0; e < 8; ++e) { const float x = (e & 1) ? bf_hi(xw[e >> 1]) : bf_lo(xw[e >> 1]); const float v = (x - st.x) * st.y * gg[e] + bb[e];
              const int dch = 32 * part + 8 * j + e, i = ((dch >> 5) << 2) | (dch & 3), dt = (dch >> 2) & 7, rho = 16 * dt + i;
              *(LAS bf16*)(VTb + rho * 256 + (((s_ >> 3) ^ i) << 4) + (s_ & 7) * 2) = (bf16)(cvt_pk_bf16(v, 0.f) & 0xffffu); } }
      if (gi < 3) {
#pragma unroll
          for (int j = 0; j < 4; ++j) xv[j] = bld128(rP, (unsigned)(s_ * DIN + 32 * part) * 2u, uni((unsigned)(t0 * DIN + 3072 + (grp + 1) * HD + 8 * j) * 2u)); }
      bf16x8 wf[4];
#pragma unroll
      for (int ks = 0; ks < 4; ++ks) if (ks <= kmax) wf[ks] = __builtin_bit_cast(bf16x8, bld128(rWS, (unsigned)(fr * 128 + 8 * gq) * 2u, uni((unsigned)(((l * 8 + grp) * 128 + 16 * wid) * 128 + 32 * ks) * 2u)));
      const unsigned lo = (unsigned)(fr * DIN + 32 * gq) * 2u; u32x4 gu[4];
#pragma unroll
      for (int np = 0; np < 4; ++np) gu[np] = bld128(rP, lo, uni((unsigned)((t0 + 16 * wid) * DIN + 2048 + grp * HD + 8 * np) * 2u));
      const float bsv = P.in[15][(size_t)(l * 8 + grp) * 128 + 16 * wid + fr];
      __syncthreads();
      f32x4 acc[8];
#pragma unroll
      for (int dt = 0; dt < 8; ++dt) { acc[dt] = (f32x4){0.f, 0.f, 0.f, 0.f};
#pragma unroll
          for (int ks = 0; ks < 4; ++ks) if (ks <= kmax) { const bf16x8 av = *(const LAS bf16x8*)(VTb + (16 * dt + fr) * 256 + (((4 * ks + gq) ^ fr) << 4)); acc[dt] = __builtin_amdgcn_mfma_f32_16x16x32_bf16(av, wf[ks], acc[dt], 0, 0, 0); } }
#pragma unroll
      for (int np = 0; np < 4; ++np) { float gv[8], o[8]; unpack8(gu[np], gv);
#pragma unroll
          for (int j = 0; j < 4; ++j) { o[j] = (acc[2 * np][j] + bsv) * gv[j]; o[4 + j] = (acc[2 * np + 1][j] + bsv) * gv[4 + j]; }
#if MIX_F8
          { u32x2 w8; w8.x = cvt4_fp8(clamp448(o[0] * HS_SCALE), clamp448(o[1] * HS_SCALE), clamp448(o[2] * HS_SCALE), clamp448(o[3] * HS_SCALE)); w8.y = cvt4_fp8(clamp448(o[4] * HS_SCALE), clamp448(o[5] * HS_SCALE), clamp448(o[6] * HS_SCALE), clamp448(o[7] * HS_SCALE));
            bst64(w8, rHSst, (unsigned)(fr * D + 32 * gq), uni((unsigned)((t0 + 16 * wid) * D + 1024 + grp * HD + 8 * np))); }
#else
          bst128(pack8(o), rPst, lo, uni((unsigned)((t0 + 16 * wid) * DIN + 2048 + grp * HD + 8 * np) * 2u));
#endif
          }
    }
    __syncthreads();
}

__device__ __forceinline__ void p_ln1_router(const Ptrs& P, int l, LAS unsigned char* lds, int vblk, int G, int tid, int wid, int lane, bool dry = false) {
    unsigned char* ws = P.ws;
    for (int i = tid; i < 8192; i += 512) { const int k = i >> 2, q = i & 3, pos = (k & ~511) | ((k & 7) << 6) | ((k >> 3) & 63);
        *(LAS f32x4*)(lds + ((size_t)(q * 2048 + pos) << 4)) = *(const f32x4*)(P.in[20] + 4 * i); }
    LAS float* RES = (LAS float*)(lds + X_AGGW);
    LAS int* LCNT = (LAS int*)(lds + X_AGGW + 2048);
    LAS float* LOGS = (LAS float*)(lds + X_AGGW + 4096);
    __syncthreads();
    const float* g1 = P.in[18] + (size_t)l * D; const float* b1 = P.in[19] + (size_t)l * D; const float* rb = P.in[21];
    bf16* X = (bf16*)(ws + WS_XN);
    unsigned* gcnt = (unsigned*)(ws + WS_CTL) + CW_CNT + l * 64;
    for (int rb0 = vblk * 64; rb0 < T; rb0 += G * 64) {
        if (tid < 16) LCNT[tid] = 0;
        u32x4 raw[2][4];
#pragma unroll
        for (int rr = 0; rr < 2; ++rr)
#pragma unroll
            for (int j = 0; j < 4; ++j) raw[rr][j] = *(const u32x4*)(X + (size_t)(rb0 + wid * 8 + rr) * D + 8 * lane + 512 * j);
        for (int pr = 0; pr < 4; ++pr) {
            const int r0 = rb0 + wid * 8 + 2 * pr;
            float v0[4][8], v1[4][8];
#pragma unroll
            for (int j = 0; j < 4; ++j) { unpack8(raw[0][j], v0[j]); unpack8(raw[1][j], v1[j]); }
            if (pr < 3) {
#pragma unroll
                for (int rr = 0; rr < 2; ++rr)
#pragma unroll
                    for (int j = 0; j < 4; ++j) raw[rr][j] = *(const u32x4*)(X + (size_t)(r0 + 2 + rr) * D + 8 * lane + 512 * j); }
            ln_row32(v0, g1, b1, lane); ln_row32(v1, g1, b1, lane);
            if (!dry) { unsigned char* X8 = ws + WS_X8;
#pragma unroll
              for (int j = 0; j < 4; ++j) { u32x2 w0, w1; w0.x = cvt4_fp8(v0[j][0], v0[j][1], v0[j][2], v0[j][3]); w0.y = cvt4_fp8(v0[j][4], v0[j][5], v0[j][6], v0[j][7]); w1.x = cvt4_fp8(v1[j][0], v1[j][1], v1[j][2], v1[j][3]); w1.y = cvt4_fp8(v1[j][4], v1[j][5], v1[j][6], v1[j][7]);
                  *(u32x2*)(X8 + (size_t)r0 * D + 8 * lane + 512 * j) = w0; *(u32x2*)(X8 + (size_t)(r0 + 1) * D + 8 * lane + 512 * j) = w1; } }
            float a0[16], a1[16];
            { f32x2 p0[8], p1[8];
#pragma unroll
              for (int e = 0; e < 8; ++e) { p0[e] = (f32x2){0.f, 0.f}; p1[e] = (f32x2){0.f, 0.f}; }
#pragma unroll
              for (int j = 0; j < 4; ++j)
#pragma unroll
                  for (int i = 0; i < 8; ++i) { const int pos = 512 * j + 64 * i + lane; const f32x2 x0 = (f32x2){v0[j][i], v0[j][i]}, x1 = (f32x2){v1[j][i], v1[j][i]};
#pragma unroll
                      for (int q = 0; q < 4; ++q) { const f32x4 w = *(const LAS f32x4*)(lds + ((size_t)(q * 2048 + pos) << 4)); const f32x2 wl = (f32x2){w[0], w[1]}, wh = (f32x2){w[2], w[3]};
                          p0[2 * q] = __builtin_elementwise_fma(x0, wl, p0[2 * q]); p0[2 * q + 1] = __builtin_elementwise_fma(x0, wh, p0[2 * q + 1]);
                          p1[2 * q] = __builtin_elementwise_fma(x1, wl, p1[2 * q]); p1[2 * q + 1] = __builtin_elementwise_fma(x1, wh, p1[2 * q + 1]); } }
#pragma unroll
              for (int e = 0; e < 8; ++e) { a0[2 * e] = p0[e].x; a0[2 * e + 1] = p0[e].y; a1[2 * e] = p1[e].x; a1[2 * e + 1] = p1[e].y; } }
#pragma unroll
            for (int e = 0; e < 16; ++e) { a0[e] = wave_sum(a0[e]); a1[e] = wave_sum(a1[e]); }
            if (lane == 0) { const int rl = wid * 8 + 2 * pr;
#pragma unroll
                for (int q = 0; q < 4; ++q) { *(LAS f32x4*)(LOGS + rl * 16 + 4 * q) = (f32x4){a0[4 * q], a0[4 * q + 1], a0[4 * q + 2], a0[4 * q + 3]}; *(LAS f32x4*)(LOGS + (rl + 1) * 16 + 4 * q) = (f32x4){a1[4 * q], a1[4 * q + 1], a1[4 * q + 2], a1[4 * q + 3]}; } }
        }
        __syncthreads();
        if (tid < 64) { const int rl = tid;
                float sc[16]; float mx = -3.0e38f;
#pragma unroll
                for (int q = 0; q < 4; ++q) { const f32x4 lg = *(const LAS f32x4*)(LOGS + rl * 16 + 4 * q); sc[4 * q] = lg[0]; sc[4 * q + 1] = lg[1]; sc[4 * q + 2] = lg[2]; sc[4 * q + 3] = lg[3]; }
#pragma unroll
                for (int e = 0; e < 16; ++e) mx = fmaxf(mx, sc[e]);
                float sum = 0.f;
#pragma unroll
                for (int e = 0; e < 16; ++e) { sc[e] = expf(sc[e] - mx); sum += sc[e]; }
                const float inv = 1.0f / sum; float sel[16];
#pragma unroll
                for (int e = 0; e < 16; ++e) { sc[e] *= inv; sel[e] = sc[e] + rb[e]; }
                int best = 0; float bestv = -3.0e38f;
#pragma unroll
                for (int gI = 0; gI < 4; ++gI) { const float s0 = sel[4 * gI], s1 = sel[4 * gI + 1], s2 = sel[4 * gI + 2], s3 = sel[4 * gI + 3];
                    const float hi01 = fmaxf(s0, s1), lo01 = fminf(s0, s1), hi23 = fmaxf(s2, s3), lo23 = fminf(s2, s3);
                    const float top1 = fmaxf(hi01, hi23), top2 = fmaxf(fminf(hi01, hi23), hi01 >= hi23 ? lo01 : lo23);
                    const float gs = top1 + top2; if (gs > bestv) { bestv = gs; best = gI; } }
                float s4[4], p4[4];
#pragma unroll
                for (int c = 0; c < 4; ++c) { s4[c] = best == 0 ? sel[c] : (best == 1 ? sel[4 + c] : (best == 2 ? sel[8 + c] : sel[12 + c])); p4[c] = best == 0 ? sc[c] : (best == 1 ? sc[4 + c] : (best == 2 ? sc[8 + c] : sc[12 + c])); }
                int i0 = 0; float m0 = s4[0];
#pragma unroll
                for (int c = 1; c < 4; ++c) if (s4[c] > m0) { m0 = s4[c]; i0 = c; }
                int i1 = (i0 == 0) ? 1 : 0; float m1 = (i0 == 0) ? s4[1] : s4[0];
#pragma unroll
                for (int c = 1; c < 4; ++c) if (c != i0 && s4[c] > m1) { m1 = s4[c]; i1 = c; }
                const float p0 = i0 == 0 ? p4[0] : (i0 == 1 ? p4[1] : (i0 == 2 ? p4[2] : p4[3])), p1 = i1 == 0 ? p4[0] : (i1 == 1 ? p4[1] : (i1 == 2 ? p4[2] : p4[3]));
                const float ws_ = 1.0f / (p0 + p1);
                RES[rl * 4 + 0] = __int_as_float(4 * best + i0); RES[rl * 4 + 1] = __int_as_float(4 * best + i1); RES[rl * 4 + 2] = p0 * ws_; RES[rl * 4 + 3] = p1 * ws_;
        }
        __syncthreads();
        int e = 0, lp = 0; float gate = 0.f;
        if (tid < 128) { const int rl = tid >> 1, k = tid & 1; e = __float_as_int(RES[rl * 4 + k]); gate = RES[rl * 4 + 2 + k]; lp = atomicAdd((int*)&LCNT[e], 1); }
        __syncthreads();
        if (tid < 16) { const int c = LCNT[tid]; LCNT[16 + tid] = (c > 0 && !dry) ? (int)__hip_atomic_fetch_add(gcnt + tid, (unsigned)c, RLX_AGENT) : 0; }
        __syncthreads();
        if (tid < 128 && !dry) { const int rl = tid >> 1, k = tid & 1, tok = rb0 + rl, pos = LCNT[16 + e] + lp;
            ((int*)(ws + WS_LTOK))[e * CAP + pos] = tok; ((float*)(ws + WS_LGATE))[e * CAP + pos] = gate; ((int*)(ws + WS_TOKSLOT))[tok * 2 + k] = (e << 16) | pos; }
        __syncthreads();
    }
}

__device__ __forceinline__ int moe_table(const Ptrs& P, int l, LAS int* tab, int tid) {
    if (tid == 0) { const unsigned* gcnt = (const unsigned*)(P.ws + WS_CTL) + CW_CNT + l * 64; int n = 0, ps = 0;
        for (int e = 0; e < NE; ++e) { const int c = (int)__hip_atomic_load(gcnt + e, RLX_AGENT); const int nt = (c + 255) >> 8; tab[160 + e] = ps; tab[176 + e] = c;
            for (int r = 0; r < nt; ++r) tab[n++] = e | (r << 8);
            ps += nt * 256; }
        tab[192] = n; }
    __syncthreads();
    return tab[192];
}

__device__ __forceinline__ void unpack_fp8x8(const u32x2 w, float (&o)[8]) {
    const f32x2 a = __builtin_amdgcn_cvt_pk_f32_fp8((int)w.x, false), b = __builtin_amdgcn_cvt_pk_f32_fp8((int)w.x, true), c = __builtin_amdgcn_cvt_pk_f32_fp8((int)w.y, false), d = __builtin_amdgcn_cvt_pk_f32_fp8((int)w.y, true);
    o[0] = a.x; o[1] = a.y; o[2] = b.x; o[3] = b.y; o[4] = c.x; o[5] = c.y; o[6] = d.x; o[7] = d.y;
}
__device__ __forceinline__ void p_ln2(const Ptrs& P, int l, LAS unsigned char* lds, int tid, const LAS int* tab, int gw, int NGW, int lane, bool dry = false) {
    unsigned char* ws = P.ws; bf16* X = (bf16*)(ws + WS_XN); const unsigned char* YS = ws + WS_YS;
    { const float* src[4] = {P.in[18] + (size_t)l * D, P.in[19] + (size_t)l * D, P.in[25] + (size_t)l * D, P.in[26] + (size_t)l * D};
#pragma unroll
      for (int a = 0; a < 4; ++a) *(LAS f32x4*)(lds + a * 8192 + tid * 16) = *(const f32x4*)(src[a] + tid * 4); }
    const LAS float* g1 = (const LAS float*)lds; const LAS float* b1 = g1 + D; const LAS float* g2 = g1 + 2 * D; const LAS float* b2 = g1 + 3 * D;
    __syncthreads();
    const int* TS = (const int*)(ws + WS_TOKSLOT);
    u32x4 rx[4]; u32x2 ry0[4], ry1[4];
    { const int m = gw; if (m < T) { const int s0 = uni(TS[m * 2]), s1 = uni(TS[m * 2 + 1]); const size_t r0 = (size_t)(tab[160 + (s0 >> 16)] + (s0 & 0xffff)), r1 = (size_t)(tab[160 + (s1 >> 16)] + (s1 & 0xffff));
#pragma unroll
        for (int j = 0; j < 4; ++j) { rx[j] = *(const u32x4*)(X + (size_t)m * D + 8 * lane + 512 * j); ry0[j] = *(const u32x2*)(YS + r0 * D + 8 * lane + 512 * j); ry1[j] = *(const u32x2*)(YS + r1 * D + 8 * lane + 512 * j); } } }
    for (int m = gw; m < T; m += NGW) {
        float v[4][8]; u32x2 cy0[4], cy1[4];
#pragma unroll
        for (int j = 0; j < 4; ++j) { unpack8(rx[j], v[j]); cy0[j] = ry0[j]; cy1[j] = ry1[j]; }
        const int mn = m + NGW;
        if (mn < T) { const int s0 = uni(TS[mn * 2]), s1 = uni(TS[mn * 2 + 1]); const size_t r0 = (size_t)(tab[160 + (s0 >> 16)] + (s0 & 0xffff)), r1 = (size_t)(tab[160 + (s1 >> 16)] + (s1 & 0xffff));
#pragma unroll
            for (int j = 0; j < 4; ++j) { rx[j] = *(const u32x4*)(X + (size_t)mn * D + 8 * lane + 512 * j); ry0[j] = *(const u32x2*)(YS + r0 * D + 8 * lane + 512 * j); ry1[j] = *(const u32x2*)(YS + r1 * D + 8 * lane + 512 * j); } }
        ln_row32(v, g1, b1, lane);
#pragma unroll
        for (int j = 0; j < 4; ++j) { float y0[8], y1[8]; unpack_fp8x8(cy0[j], y0); unpack_fp8x8(cy1[j], y1);
#pragma unroll
            for (int i = 0; i < 8; ++i) v[j][i] = ALPHA * v[j][i] + (y0[i] + y1[i]) * (1.0f / YS_SCALE); }
        ln_row32(v, g2, b2, lane);
        if (dry) continue;
        if (l == DEPTH - 1) {
#pragma unroll
            for (int j = 0; j < 4; ++j) { *(f32x4*)(P.out + (size_t)m * D + 8 * lane + 512 * j) = (f32x4){v[j][0], v[j][1], v[j][2], v[j][3]}; *(f32x4*)(P.out + (size_t)m * D + 8 * lane + 512 * j + 4) = (f32x4){v[j][4], v[j][5], v[j][6], v[j][7]}; }
        } else { store_row_bf16(v, X + (size_t)m * D, lane); if (PROJ_F8) store_row_fp8(v, ws + WS_X8 + (size_t)m * D, lane); }
    }
}

__device__ __forceinline__ int TID() { int t = threadIdx.x; asm volatile("" : "+v"(t)); return t; }
constexpr int N_PHASES = 1 + 8 * DEPTH;
struct Args { Ptrs p; int ph_lo, ph_hi; };
__global__ void __launch_bounds__(NWAVES * 64, 2) mk_fwd(Args args) {
    extern __shared__ __attribute__((aligned(16))) unsigned char lds_raw[];
    LAS unsigned char* lds = (LAS unsigned char*)lds_raw;
    const int tid = threadIdx.x, lane = tid & 63, wid = __builtin_amdgcn_readfirstlane(tid >> 6);
    const int G = gridDim.x; const int bx = blockIdx.x; const int vcu = (G % 8 == 0) ? (bx % 8) * (G / 8) + bx / 8 : bx;
    const int gw = vcu * NWAVES + wid, NGW = G * NWAVES;
    const Ptrs& P = args.p;
    unsigned char* ws = P.ws;
    volatile LAS unsigned* MISC = (volatile LAS unsigned*)(lds + X_MISC);
    LAS int* TAB = (LAS int*)(lds + X_TAB);
    if (tid < 64) MISC[tid] = 0u;
    __syncthreads();
    XcdBarrier bar = xcd_barrier_post((unsigned*)(ws + WS_CTL) + CW_BAR, MISC + 8);
    const int lo = args.ph_lo, hi = args.ph_hi;
#ifndef PHMASK
#define PHMASK 0x3ff
#endif
#define PHON(b) (((PHMASK) >> (b)) & 1)
#ifndef REPEAT_MASK
#define REPEAT_MASK 0
#endif
#ifndef PROBE_FOLD
#define PROBE_FOLD 0
#endif
#ifndef XPROBE
#define XPROBE 0
#endif
#define REPS(b) for (int rep_ = 0; rep_ <= ((REPEAT_MASK >> (b)) & 1); ++rep_)
#define REPSYNC() do { if (rep_ == 0 && REPEAT_MASK) xcd_barrier(bar); } while (0)
#define IN(k) (lo <= (k) && (k) < hi)
#define SEAM(k) do { if (IN(k) && IN((k) + 1)) xcd_barrier(bar); } while (0)

    if (PHON(0) && IN(0)) { REPS(0) { p_prologue(P, lds, gw, NGW, wid, TID() & 63, gridDim.x == 256); if ((REPEAT_MASK >> 0) & 1) REPSYNC(); } } SEAM(0);

    for (int l = 0; l < DEPTH; ++l) {
        const int pb = 1 + 8 * l;
        if (PHON(1) && IN(pb + 0)) REPS(1) {
#if PROJ_F8
            const bool dryp = ((REPEAT_MASK >> 1) & 1) && rep_ == 0;

            const int slot = blockIdx.x >> 3; const bool sp0 = gridDim.x == 256 && l == 0, is_conv = slot & 1;
            if (sp0 && is_conv) { cv_run<1, CV_DEPTH>(P, ((bx & 7) * 16 + (slot >> 1)) * NWAVES + wid, 128 * NWAVES, TID() & 63); }
            {
            pg8::RegOrder S{(const char*)(ws + WS_X8), (const char*)(ws + WS_WIN) + (size_t)l * DIN * D, D, D, T / 256, DIN / 256, sp0 ? 128 : G, sp0 ? (is_conv ? 128 * (16 - PROJ_R2) : 0) + (slot >> 1) * 8 + (bx & 7) : bx, 1, PROJ_WGM, (dryp && PROBE_FOLD) ? 1 : 0, sp0 ? (is_conv ? PROJ_R2 : 16 - PROJ_R2) : (1 << 30)};
            pg8::EpiProj E{(bf16*)(ws + WS_PROJ), 1.0f / WIN_SCALE, dryp};
            pg8::gemm_phase<pg8::EpiProj, pg8::RegOrder, true>(lds, D, S, E, TID());
            }
#else
            pg8::RegOrder S{(const char*)(ws + WS_XN), (const char*)(ws + WS_WIN) + (size_t)l * DIN * D * 2, D, D, T / 256, DIN / 256, G, bx, 2};
            pg8::EpiProj E{(bf16*)(ws + WS_PROJ), 1.0f};
            pg8::gemm_phase(lds, D, S, E, TID());
#endif
            if ((REPEAT_MASK >> 1) & 1) REPSYNC();
        } SEAM(pb + 0);
        if (PHON(3) && IN(pb + 1)) REPS(3) { const bool dry = ((REPEAT_MASK >> 3) & 1) && rep_ == 0;
            if (!(dry && XPROBE == 2)) { if (vcu < 512 && vcu < G) rnn_unit(P, l, vcu, lds, tid, wid, dry); }
            if (!(dry && XPROBE == 1)) { for (int u = vcu; u < 256; u += G) sgu_half_unit(P, l, u, lds, tid, wid, dry); }
            if (!(dry && XPROBE == 2)) { for (int u = vcu + G; u < 512; u += G) rnn_unit(P, l, u, lds, tid, wid, dry); }
            if ((REPEAT_MASK >> 3) & 1) REPSYNC();
        } SEAM(pb + 1);
        if (PHON(4) && IN(pb + 2)) REPS(4) {
#if MIX_F8
            pg8::RegOrder S{(const char*)(ws + WS_HS8), (const char*)(ws + WS_WCAT) + (size_t)l * D * D, D, D, T / 256, D / 256, G, bx, 1, MIX_WGM};
            pg8::EpiYab E{(const bf16*)(ws + WS_PROJ), (bf16*)(ws + WS_MERGED)};
            pg8::gemm_phase<pg8::EpiYab, pg8::RegOrder, true>(lds, D, S, E, TID());
#else
            pg8::RegOrder S{(const char*)(ws + WS_PROJ) + 1024 * 2, (const char*)(ws + WS_WCAT) + (size_t)l * D * D * 2, DIN, D, T / 256, D / 256, G, bx, 2};
            pg8::EpiYab E{(const bf16*)(ws + WS_PROJ), (bf16*)(ws + WS_MERGED)};
            pg8::gemm_phase(lds, D, S, E, TID());
#endif
            if ((REPEAT_MASK >> 4) & 1) REPSYNC();
        } SEAM(pb + 2);
        if (PHON(5) && IN(pb + 3)) REPS(5) { const bool dry = ((REPEAT_MASK >> 5) & 1) && rep_ == 0;
#if MIX_F8
            pg8::RegOrder S{(const char*)(ws + WS_MERGED), (const char*)(ws + WS_WOUT) + (size_t)l * D * D, D, D, T / 256, D / 256, G, bx, 1, MIX_WGM};
            pg8::EpiWout E{(bf16*)(ws + WS_XN), dry};
            pg8::gemm_phase<pg8::EpiWout, pg8::RegOrder, true>(lds, D, S, E, TID());
#else
            pg8::RegOrder S{(const char*)(ws + WS_MERGED), (const char*)(ws + WS_WOUT) + (size_t)l * D * D * 2, D, D, T / 256, D / 256, G, bx, 2};
            pg8::EpiWout E{(bf16*)(ws + WS_XN), dry};
            pg8::gemm_phase(lds, D, S, E, TID());
#endif
            if ((REPEAT_MASK >> 5) & 1) REPSYNC();
        } SEAM(pb + 3);
        if (PHON(6) && IN(pb + 4)) REPS(6) { const bool dry = ((REPEAT_MASK >> 6) & 1) && rep_ == 0; const int t_ = TID(); p_ln1_router(P, l, lds, vcu, G, t_, wid, t_ & 63, dry); if ((REPEAT_MASK >> 6) & 1) REPSYNC(); } SEAM(pb + 4);
        if (PHON(7) && IN(pb + 5)) REPS(7) {
            const int nrt = moe_table(P, l, TAB, tid);
            pg8::MoeOrder1 S{(const char*)(ws + WS_X8), (const char*)(ws + WS_W13) + (size_t)l * NE * 2816 * D, (const int*)(ws + WS_LTOK), TAB, nrt, 11, G, bx, MOE_WGM};
            pg8::EpiMoe1 E{(unsigned char*)(ws + WS_HDN)};
            pg8::gemm_phase<pg8::EpiMoe1, pg8::MoeOrder1, true>(lds, D, S, E, TID());
            if ((REPEAT_MASK >> 7) & 1) REPSYNC();
        } SEAM(pb + 5);
        if (PHON(8) && IN(pb + 6)) REPS(8) {
            const int nrt = moe_table(P, l, TAB, tid);
            pg8::MoeOrder2 S{(const char*)(ws + WS_HDN), (const char*)(ws + WS_W2) + (size_t)l * NE * D * DEP, TAB, nrt, 8, G, bx, MOE_WGM};
            pg8::EpiMoe2 E{ws + WS_YS, (const float*)(ws + WS_LGATE), TAB};
            pg8::gemm_phase<pg8::EpiMoe2, pg8::MoeOrder2, true, true>(lds, DEP, S, E, TID());
            if ((REPEAT_MASK >> 8) & 1) REPSYNC();
        } SEAM(pb + 6);
        if (PHON(9) && IN(pb + 7)) REPS(9) { const bool dry = ((REPEAT_MASK >> 9) & 1) && rep_ == 0; (void)moe_table(P, l, TAB, tid); { const int t_ = TID(); p_ln2(P, l, lds, t_, TAB, gw, NGW, t_ & 63, dry); } if ((REPEAT_MASK >> 9) & 1) REPSYNC(); } SEAM(pb + 7);
    }
#undef IN
#undef SEAM
}

extern "C" void kernel_launch(void* const* d_in, const int* in_sizes, int n_in, void* d_out, int out_size, void* d_ws, size_t ws_size, hipStream_t stream) {
    static int grid = 0;
    if (grid == 0) {
        if (n_in != 27 || out_size != T * D || ws_size < WS_END) { fprintf(stderr, "kernel_launch: unexpected shapes (n_in %d, out %d, ws %zu)\n", n_in, out_size, ws_size); grid = -1; return; }
        int dev = 0, cus = 0, per_cu = 0;
        if (hipGetDevice(&dev) != hipSuccess || hipDeviceGetAttribute(&cus, hipDeviceAttributeMultiprocessorCount, dev) != hipSuccess) { grid = -1; return; }
        if (hipFuncSetAttribute((const void*)mk_fwd, hipFuncAttributeMaxDynamicSharedMemorySize, LDS_BYTES) != hipSuccess) { fprintf(stderr, "kernel_launch: hipFuncSetAttribute failed\n"); grid = -1; return; }
        if (hipOccupancyMaxActiveBlocksPerMultiprocessor(&per_cu, (const void*)mk_fwd, NWAVES * 64, LDS_BYTES) != hipSuccess || per_cu < 1) { fprintf(stderr, "kernel_launch: occupancy query says %d\n", per_cu); }
        (void)hipGetLastError();
        grid = cus;
    }
    if (grid < 0) return;
    (void)hipMemsetAsync((char*)d_ws + WS_CTL, 0, CTL_ZERO_BYTES, stream);
    Args a{};
    for (int i = 0; i < 27; ++i) a.p.in[i] = (const float*)d_in[i];
    a.p.out = (float*)d_out; a.p.ws = (unsigned char*)d_ws;
#if MK_N_LAUNCHES == 1
    a.ph_lo = 0; a.ph_hi = N_PHASES;
    hipLaunchKernelGGL(mk_fwd, dim3(grid), dim3(NWAVES * 64), LDS_BYTES, stream, a);
#else
#ifndef PH_STOP
#define PH_STOP N_PHASES
#endif
    for (int p = 0; p < PH_STOP; ++p) { a.ph_lo = p; a.ph_hi = p + 1; hipLaunchKernelGGL(mk_fwd, dim3(grid), dim3(NWAVES * 64), LDS_BYTES, stream, a); }
#endif
}
```
